# Optimizing an MI355X kernel written in HIP

```python
import math
import jax, jax.numpy as jnp
from jax import lax
import numpy as np

D_MODEL = 2048
BATCH = 8
SEQ = 4096
DEPTH = 1

N_Q_HEADS = 32
N_KV_HEADS = 4
GROUP = N_Q_HEADS // N_KV_HEADS
HEAD_DIM = 64
ATTN_WIDTH = N_Q_HEADS * HEAD_DIM
KV_WIDTH = N_KV_HEADS * HEAD_DIM
WINDOW = 128
BLOCK = 128
NEG_INF = -1e30
N_BUCKETS = 32
MAX_DISTANCE = 128
LRU_WIDTH = D_MODEL
LRU_BLOCKS = 16
LRU_BLOCK_W = LRU_WIDTH // LRU_BLOCKS
CONV_WIDTH = 4
LRU_C = 8.0
D_FF = 4 * D_MODEL
EPS = 1e-6
IN_SPLITS = (LRU_WIDTH, LRU_WIDTH, ATTN_WIDTH, KV_WIDTH, KV_WIDTH, D_MODEL, D_MODEL)
IN_WIDTH = sum(IN_SPLITS)

kernel_name = "hybrid_rglru_swa_sink_sqrelu_adaln"


def _rms_norm(x, g):
    xf = x.astype(jnp.float32)
    y = xf * lax.rsqrt(jnp.mean(xf * xf, axis=-1, keepdims=True) + EPS)
    return (y * g.astype(jnp.float32)).astype(x.dtype)


def _modulate(h, shift, scale):
    return h * (1.0 + scale[:, None, :]) + shift[:, None, :]


def _causal_depthwise_conv(x, w, b):
    s = x.shape[1]
    xp = jnp.pad(x, ((0, 0), (CONV_WIDTH - 1, 0), (0, 0)))
    y = b
    for k in range(CONV_WIDTH):
        y = y + xp[:, k:k + s] * w[k]
    return y


def _rg_lru(x, wa, ba, wx, bx, lam):
    b_, s, w = x.shape
    xb = x.reshape(b_, s, LRU_BLOCKS, LRU_BLOCK_W)
    r = jax.nn.sigmoid(jnp.einsum("bshi,hij->bshj", xb, wa).reshape(b_, s, w) + ba)
    i = jax.nn.sigmoid(jnp.einsum("bshi,hij->bshj", xb, wx).reshape(b_, s, w) + bx)
    log_a = -LRU_C * r.astype(jnp.float32) * jax.nn.softplus(-lam.astype(jnp.float32))
    a = jnp.exp(log_a)
    mult = jnp.sqrt(-jnp.expm1(2.0 * log_a))
    mult = jnp.where(jnp.arange(s)[None, :, None] == 0, 1.0, mult)
    u = mult * (i * x).astype(jnp.float32)

    def step(h, au):
        a_t, u_t = au
        h = a_t * h + u_t
        return h, h

    h0 = jnp.zeros((b_, w), jnp.float32)
    _, hs = lax.scan(step, h0, (jnp.swapaxes(a, 0, 1), jnp.swapaxes(u, 0, 1)))
    return jnp.swapaxes(hs, 0, 1).astype(x.dtype)


def _t5_causal_bucket(rel):
    max_exact = N_BUCKETS // 2
    relf = jnp.maximum(rel, 1).astype(jnp.float32)
    large = max_exact + (jnp.log(relf / max_exact) / math.log(MAX_DISTANCE / max_exact)
                         * (N_BUCKETS - max_exact)).astype(jnp.int32)
    large = jnp.minimum(large, N_BUCKETS - 1)
    return jnp.where(rel < max_exact, rel, large)


def _band_bias_and_mask(rel_bias, n_blocks):
    qi = jnp.arange(BLOCK)[:, None]
    ki = jnp.arange(2 * BLOCK)[None, :]
    rel = qi + BLOCK - ki
    bucket = _t5_causal_bucket(jnp.maximum(rel, 0))
    bias = jnp.transpose(rel_bias[bucket], (2, 0, 1)).astype(jnp.float32)
    bias = bias.reshape(N_KV_HEADS, GROUP, BLOCK, 2 * BLOCK)
    kpos = jnp.arange(n_blocks)[:, None, None] * BLOCK - BLOCK + ki[None]
    valid = (kpos >= 0) & (rel[None] >= 0) & (rel[None] < WINDOW)
    return bias, valid


def _swa_sink_attention(q, k, v, sinks, rel_bias):
    b_, s, _ = q.shape
    n = s // BLOCK
    bias, valid = _band_bias_and_mask(rel_bias, n)
    q = q.reshape(b_, n, BLOCK, N_KV_HEADS, GROUP, HEAD_DIM)

    def band(t):
        t = t.reshape(b_, s, N_KV_HEADS, HEAD_DIM)
        tp = jnp.pad(t, ((0, 0), (BLOCK, 0), (0, 0), (0, 0)))
        tp = tp.reshape(b_, n + 1, BLOCK, N_KV_HEADS, HEAD_DIM)
        return jnp.concatenate([tp[:, :-1], tp[:, 1:]], axis=2)

    kb, vb = band(k), band(v)
    logits = jnp.einsum("bnqkgd,bnskd->bnkgqs", q, kb,
                        preferred_element_type=jnp.float32) * (HEAD_DIM ** -0.5)
    logits = jnp.where(valid[None, :, None, None], logits + bias[None, None], NEG_INF)
    sink = sinks.astype(jnp.float32).reshape(N_KV_HEADS, GROUP)[None, None, :, :, None, None]
    m = jnp.maximum(jnp.max(logits, axis=-1, keepdims=True), sink)
    e = jnp.exp(logits - m)
    p = e / (jnp.sum(e, axis=-1, keepdims=True) + jnp.exp(sink - m))
    o = jnp.einsum("bnkgqs,bnskd->bnqkgd", p.astype(vb.dtype), vb)
    return o.reshape(b_, s, ATTN_WIDTH)


def setup_inputs(seed: int = 0) -> dict:
    key = jax.random.key(seed)
    ks = jax.random.split(key, 24)
    f32 = jnp.float32
    L, D = DEPTH, D_MODEL

    def nrm(k, shape, scale):
        return jax.random.normal(k, shape, f32) * scale

    a_c = jax.random.uniform(ks[12], (L, LRU_WIDTH), f32, 0.9, 0.999)
    a0 = a_c ** (1.0 / LRU_C)
    lam = jnp.log(a0) - jnp.log1p(-a0)
    return {
        "x": nrm(ks[0], (BATCH, SEQ, D), 1.0),
        "c": nrm(ks[1], (BATCH, D), 1.0),
        "w_ada": nrm(ks[2], (L, D, 6 * D), 0.5 * D ** -0.5),
        "b_ada": nrm(ks[3], (L, 6 * D), 0.02),
        "norm1_g": 1.0 + nrm(ks[4], (L, D), 0.02),
        "w_in": nrm(ks[5], (L, D, IN_WIDTH), D ** -0.5),
        "conv_w": nrm(ks[6], (L, CONV_WIDTH, LRU_WIDTH), CONV_WIDTH ** -0.5),
        "conv_b": nrm(ks[7], (L, LRU_WIDTH), 0.02),
        "lru_wa": nrm(ks[8], (L, LRU_BLOCKS, LRU_BLOCK_W, LRU_BLOCK_W), LRU_BLOCK_W ** -0.5),
        "lru_ba": nrm(ks[9], (L, LRU_WIDTH), 0.02),
        "lru_wx": nrm(ks[10], (L, LRU_BLOCKS, LRU_BLOCK_W, LRU_BLOCK_W), LRU_BLOCK_W ** -0.5),
        "lru_bx": nrm(ks[11], (L, LRU_WIDTH), 0.02),
        "lru_lambda": lam,
        "w_lru_out": nrm(ks[13], (L, LRU_WIDTH, D), LRU_WIDTH ** -0.5),
        "w_attn_out": nrm(ks[14], (L, ATTN_WIDTH, D), ATTN_WIDTH ** -0.5),
        "attn_sinks": nrm(ks[15], (L, N_Q_HEADS), 1.0),
        "rel_bias": nrm(ks[16], (N_BUCKETS, N_Q_HEADS), 0.5),
        "w_out": nrm(ks[17], (L, D, D), D ** -0.5),
        "norm2_g": 1.0 + nrm(ks[18], (L, D), 0.02),
        "w_ff1": nrm(ks[19], (L, D, D_FF), D ** -0.5),
        "w_ff2": nrm(ks[20], (L, D_FF, D), D_FF ** -0.5),
        "final_g": 1.0 + nrm(ks[21], (D,), 0.02),
    }


def reference(x, c, w_ada, b_ada, norm1_g, w_in, conv_w, conv_b, lru_wa, lru_ba, lru_wx,
              lru_bx, lru_lambda, w_lru_out, w_attn_out, attn_sinks, rel_bias, w_out,
              norm2_g, w_ff1, w_ff2, final_g):
    split_idx = list(np.cumsum(IN_SPLITS)[:-1])
    c_act = jax.nn.silu(c)
    for l in range(DEPTH):
        mod = jnp.dot(c_act, w_ada[l]) + b_ada[l]
        shift1, scale1, gate1, shift2, scale2, gate2 = jnp.split(mod, 6, axis=-1)

        h = _modulate(_rms_norm(x, norm1_g[l]), shift1, scale1)
        proj = jnp.einsum("bsd,de->bse", h, w_in[l])
        lru_x, lru_gate, q, k, v, g_a, g_b = jnp.split(proj, split_idx, axis=-1)

        xc = _causal_depthwise_conv(lru_x, conv_w[l], conv_b[l])
        rec = _rg_lru(xc, lru_wa[l], lru_ba[l], lru_wx[l], lru_bx[l], lru_lambda[l])
        y_a = jnp.einsum("bsw,wd->bsd", rec * jax.nn.gelu(lru_gate, approximate=True),
                         w_lru_out[l])

        att = _swa_sink_attention(q, k, v, attn_sinks[l], rel_bias)
        y_b = jnp.einsum("bsw,wd->bsd", att, w_attn_out[l])

        merged = jax.nn.sigmoid(g_a) * y_a + jax.nn.sigmoid(g_b) * y_b
        x = x + gate1[:, None, :] * jnp.einsum("bsd,de->bse", merged, w_out[l])

        h2 = _modulate(_rms_norm(x, norm2_g[l]), shift2, scale2)
        ff = jnp.square(jax.nn.relu(jnp.einsum("bsd,df->bsf", h2, w_ff1[l])))
        x = x + gate2[:, None, :] * jnp.einsum("bsf,fd->bsd", ff, w_ff2[l])

    return _rms_norm(x, final_g)
```

```cpp
#include <hip/hip_runtime.h>
#include <hip/hip_cooperative_groups.h>
#include <cstdio>
#include <cstdint>
namespace cg = cooperative_groups;

#define LAS __attribute__((address_space(3)))
typedef unsigned short bf16_t;
typedef short bf16x8 __attribute__((ext_vector_type(8)));
typedef float f32x4 __attribute__((ext_vector_type(4)));
typedef float f32x2 __attribute__((ext_vector_type(2)));
typedef float f32x16 __attribute__((ext_vector_type(16)));
typedef unsigned u32x4 __attribute__((ext_vector_type(4)));
typedef unsigned u32x2 __attribute__((ext_vector_type(2)));

constexpr int DM = 2048, NB = 8, SEQ = 4096, MTOK = NB * SEQ;
constexpr int INW = 10752, DFF = 8192, NMOD = 6 * DM;
constexpr int C_LX = 0, C_LG = 2048, C_Q = 4096, C_K = 6144, C_V = 6400, C_GA = 6656, C_GB = 8704;
constexpr float EPS = 1e-6f, NEGF = -1e30f, LOG2E = 1.4426950408889634f;

constexpr size_t WS_MOD = 0;
constexpr size_t WS_WIN = 1u << 20;
constexpr size_t WS_WM = WS_WIN + (size_t)INW * DM * 2;
constexpr size_t WS_WO = WS_WM + (size_t)DM * 4096 * 2;
constexpr size_t WS_W1 = WS_WO + (size_t)DM * DM * 2;
constexpr size_t WS_W2 = WS_W1 + (size_t)DFF * DM * 2;
constexpr size_t WS_WA = WS_W2 + (size_t)DFF * DM * 2;
constexpr size_t WS_WX = WS_WA + (size_t)128 * DM * 2;
constexpr size_t WS_H = WS_WX + (size_t)128 * DM * 2;
constexpr size_t WS_PROJ = WS_H + (size_t)MTOK * DM * 2;
constexpr size_t WS_END = WS_PROJ + (size_t)MTOK * INW * 2;

constexpr int LDS_BYTES = 147456;

struct Params {
    const float *x, *c, *w_ada, *b_ada, *norm1_g, *w_in, *conv_w, *conv_b, *lru_wa, *lru_ba, *lru_wx, *lru_bx, *lru_lambda,
        *w_lru_out, *w_attn_out, *attn_sinks, *rel_bias, *w_out, *norm2_g, *w_ff1, *w_ff2, *final_g;
    float* out; unsigned char* ws;
};

__device__ __forceinline__ unsigned cvt_pk_bf16(float lo, float hi) { unsigned r; asm volatile("v_cvt_pk_bf16_f32 %0, %1, %2" : "=v"(r) : "v"(lo), "v"(hi)); return r; }
__device__ __forceinline__ float bf_lo(unsigned w) { return __uint_as_float(w << 16); }
__device__ __forceinline__ float bf_hi(unsigned w) { return __uint_as_float(w & 0xffff0000u); }
__device__ __forceinline__ float fast_sigmoid(float x) { return __builtin_amdgcn_rcpf(1.0f + __builtin_amdgcn_exp2f(-LOG2E * x)); }
__device__ __forceinline__ float gelu_tanh(float x) { const float u = x + 0.044715f * x * x * x; return x * __builtin_amdgcn_rcpf(1.0f + __builtin_amdgcn_exp2f(-2.3022082f * u)); }
__device__ __forceinline__ float wave_sum(float v) {
#pragma unroll
    for (int o = 1; o < 64; o <<= 1) v += __shfl_xor(v, o);
    return v;
}

namespace pg8 {
constexpr int BM = 256, BK = 64, HALF = 128, HTB = HALF * BK * 2, STAGE_BYTES = 8 * HTB, NXCD = 8, WGM = 8;
__host__ __device__ __forceinline__ int lds_byte(int r, int c) { const int st = (r >> 4) * 2 + (c >> 5), rr = r & 15, cc = c & 31, ob = rr * 64 + cc * 2; return st * 1024 + (ob ^ (((ob >> 9) & 1) << 5)); }
__host__ __device__ __forceinline__ void stage_rc(int b, int& R, int& C) { const int st = b / 1024, sb = b % 1024, swz = sb ^ (((sb >> 9) & 1) << 5); R = (st >> 1) * 16 + swz / 64; C = (st & 1) * 32 + (swz % 64) / 2; }
__host__ __device__ __forceinline__ int perm32(int rho) { const int n = rho >> 4, i = rho & 15; return 8 * (i >> 2) + 4 * n + (i & 3); }

struct Unit { int pm, pn; };
struct Gemm { const bf16_t* A; const bf16_t* Bt; int M, N, K, lda, ldb; };

struct StaticOrder {
    int nM, nN, nwg, G, c;
    __device__ void init(int M, int N, int G_, int c_) { nM = M / BM; nN = N / BM; nwg = nM * nN; G = G_; c = c_; }
    __device__ bool next(int i, Unit& u) const {
        const long L = (long)i * G + c; if (L >= nwg) return false;
        int wgid = (int)L; { const int q = nwg / NXCD, r = nwg % NXCD, xcd = wgid % NXCD, off = wgid / NXCD; wgid = (xcd < r ? xcd * (q + 1) : r * (q + 1) + (xcd - r) * q) + off; }
        const int nig = WGM * nN, gid = wgid / nig, fm = gid * WGM, gsz = (nM - fm) < WGM ? (nM - fm) : WGM;
        u.pm = fm + ((wgid % nig) % gsz); u.pn = (wgid % nig) / gsz; return true;
    }
};

template <class Epi>
__device__ __forceinline__ void gemm_phase(LAS unsigned char* lds, const Gemm g, const StaticOrder& S, const Epi& E) {
    int tid_ = threadIdx.x; asm volatile("" : "+v"(tid_));
    const int tid = tid_, wid = __builtin_amdgcn_readfirstlane(tid >> 6), lane = tid & 63, wr = wid >> 2, wc = wid & 3, fr = lane & 15, fq = lane >> 4;
    const int K = g.K, nt = K / BK;
    unsigned voffA[2], voffB[2];
#pragma unroll
    for (int i = 0; i < 2; ++i) { int R, C; stage_rc(tid * 16 + i * 8192, R, C); const int Rb = (R & ~31) + perm32(R & 31);
        voffA[i] = (unsigned)(R * g.lda + C) * 2u; voffB[i] = (unsigned)(Rb * g.ldb + C) * 2u; }
    const size_t kstep = (size_t)(BK * 2);
    const size_t hstepA = (size_t)HALF * g.lda * 2, hstepB = (size_t)HALF * g.ldb * 2;
    const size_t tstepA = 2 * hstepA, tstepB = 2 * hstepB;
    const unsigned ldsw = (unsigned)wid * 1024u;
    const int aoff = lds_byte(wr * 64 + fr, fq * 8), boff = lds_byte(wc * 32 + fr, fq * 8);
#define PG8_SA(b, h) (((b) * 2 + (h)) * HTB)
#define PG8_SB(b, h) ((4 + (b) * 2 + (h)) * HTB)
#define PG8_STAGE(bufoff, gbase, voff) do { _Pragma("unroll") for (int _i = 0; _i < 2; ++_i) \
        __builtin_amdgcn_global_load_lds((const unsigned*)((const char*)(gbase) + (voff)[_i]), (LAS unsigned*)(lds + (bufoff) + ldsw + _i * 8192), 16, 0, 0); } while (0)
#define PG8_LDA(dst, b, h) do { _Pragma("unroll") for (int m = 0; m < 4; ++m) _Pragma("unroll") for (int k = 0; k < 2; ++k) dst[m][k] = *(const LAS bf16x8*)(lds + PG8_SA(b, h) + aoff + m * 2048 + k * 1024); } while (0)
#define PG8_LDB(dst, b, h) do { _Pragma("unroll") for (int n = 0; n < 2; ++n) _Pragma("unroll") for (int k = 0; k < 2; ++k) dst[n][k] = *(const LAS bf16x8*)(lds + PG8_SB(b, h) + boff + n * 2048 + k * 1024); } while (0)
#define PG8_MMA(ai, bj, At, Bt) do { __builtin_amdgcn_s_setprio(1); _Pragma("unroll") for (int m = 0; m < 4; ++m) _Pragma("unroll") for (int n = 0; n < 2; ++n) _Pragma("unroll") for (int k = 0; k < 2; ++k) \
        acc[ai][bj][m][n] = __builtin_amdgcn_mfma_f32_16x16x32_bf16(Bt[n][k], At[m][k], acc[ai][bj][m][n], 0, 0, 0); __builtin_amdgcn_s_setprio(0); } while (0)
#define PG8_WAIT_V(n) asm volatile("s_waitcnt vmcnt(" #n ")" ::: "memory")
#define PG8_WAIT_L(n) asm volatile("s_waitcnt lgkmcnt(" #n ")" ::: "memory")
#define PG8_BAR __builtin_amdgcn_s_barrier()
#define PG8_SCHED __builtin_amdgcn_sched_barrier(0)
    Unit cur, nxt; int ui = 0;
    if (!S.next(0, cur)) return;
    f32x4 acc[2][2][4][2];
#pragma unroll
    for (int a = 0; a < 2; ++a)
#pragma unroll
        for (int b = 0; b < 2; ++b)
#pragma unroll
            for (int m = 0; m < 4; ++m)
#pragma unroll
                for (int n = 0; n < 2; ++n) acc[a][b][m][n] = (f32x4){0.f, 0.f, 0.f, 0.f};
    bf16x8 At[4][2], B0[2][2], B1[2][2];
    const char* cA = (const char*)g.A + (size_t)cur.pm * tstepA; const char* cB = (const char*)g.Bt + (size_t)cur.pn * tstepB;
    PG8_STAGE(PG8_SB(0, 0), cB, voffB); PG8_STAGE(PG8_SB(0, 1), cB + hstepB, voffB); PG8_STAGE(PG8_SA(0, 0), cA, voffA); PG8_STAGE(PG8_SA(0, 1), cA + hstepA, voffA);
    if (wr == 1) PG8_BAR;
    PG8_WAIT_V(2); PG8_BAR;
    PG8_STAGE(PG8_SB(1, 0), cB + kstep, voffB); PG8_STAGE(PG8_SA(1, 0), cA + kstep, voffA); PG8_STAGE(PG8_SB(1, 1), cB + hstepB + kstep, voffB);
    PG8_WAIT_V(6); PG8_BAR;
    for (;;) {
        const bool has_next = S.next(ui + 1, nxt);
        const char* nA = has_next ? (const char*)g.A + (size_t)nxt.pm * tstepA : cA; const char* nB = has_next ? (const char*)g.Bt + (size_t)nxt.pn * tstepB : cB;
        for (int t = 0; t < nt; t += 2) {
            if constexpr (Epi::HAS_MID) { if (t == E.mid_t) E.mid(acc, cur, wr, wc, fr, fq); }
            const bool last = (t == nt - 2);
            const char* a1 = cA + (size_t)(t + 1) * kstep;
            const char* a2 = last ? nA : cA + (size_t)(t + 2) * kstep; const char* b2 = last ? nB : cB + (size_t)(t + 2) * kstep;
            const char* a3 = a2 + kstep; const char* b3 = b2 + kstep;
            PG8_LDB(B0, 0, 0); PG8_LDB(B1, 0, 1); PG8_SCHED; PG8_LDA(At, 0, 0); PG8_STAGE(PG8_SA(1, 1), a1 + hstepA, voffA);
            PG8_WAIT_V(8); PG8_WAIT_L(0); PG8_BAR; PG8_MMA(0, 0, At, B0); PG8_MMA(0, 1, At, B1); PG8_BAR; PG8_SCHED;
            PG8_LDA(At, 0, 1); PG8_STAGE(PG8_SB(0, 0), b2, voffB); PG8_STAGE(PG8_SB(0, 1), b2 + hstepB, voffB); PG8_STAGE(PG8_SA(0, 0), a2, voffA);
            PG8_WAIT_V(8); PG8_WAIT_L(0); PG8_BAR; PG8_MMA(1, 0, At, B0); PG8_MMA(1, 1, At, B1); PG8_BAR; PG8_SCHED;
            PG8_LDB(B0, 1, 0); PG8_LDB(B1, 1, 1); PG8_SCHED; PG8_LDA(At, 1, 0); PG8_STAGE(PG8_SA(0, 1), a2 + hstepA, voffA);
            PG8_WAIT_V(8); PG8_WAIT_L(0); PG8_BAR; PG8_MMA(0, 0, At, B0); PG8_MMA(0, 1, At, B1); PG8_BAR; PG8_SCHED;
            PG8_LDA(At, 1, 1); PG8_STAGE(PG8_SB(1, 0), b3, voffB); PG8_STAGE(PG8_SB(1, 1), b3 + hstepB, voffB); PG8_STAGE(PG8_SA(1, 0), a3, voffA);
            PG8_WAIT_V(8); PG8_WAIT_L(0); PG8_BAR; PG8_MMA(1, 0, At, B0); PG8_MMA(1, 1, At, B1); PG8_BAR; PG8_SCHED;
        }
        if (wr == 0) PG8_BAR;
        E(acc, cur, wr, wc, fr, fq);
        if (!has_next) break;
#pragma unroll
        for (int a = 0; a < 2; ++a)
#pragma unroll
            for (int b = 0; b < 2; ++b)
#pragma unroll
                for (int m = 0; m < 4; ++m)
#pragma unroll
                    for (int n = 0; n < 2; ++n) acc[a][b][m][n] = (f32x4){0.f, 0.f, 0.f, 0.f};
        cur = nxt; cA = nA; cB = nB; ++ui;
        if (wr == 1) PG8_BAR;
    }
    PG8_WAIT_V(0);
    PG8_BAR;
#undef PG8_SA
#undef PG8_SB
#undef PG8_STAGE
#undef PG8_LDA
#undef PG8_LDB
#undef PG8_MMA
#undef PG8_WAIT_V
#undef PG8_WAIT_L
#undef PG8_BAR
#undef PG8_SCHED
}

typedef f32x4 Acc[2][2][4][2];

struct EpiProj {
    static constexpr bool HAS_MID = false; int mid_t;
    bf16_t* O; int ldc;
    template <int ACT> __device__ __forceinline__ void body(const Acc& acc, const Unit& u, int wr, int wc, int fr, int fq) const {
        const int row0 = u.pm * BM + wr * 64 + fr, col0 = u.pn * BM + wc * 32 + 8 * fq;
#pragma unroll
        for (int ai = 0; ai < 2; ++ai)
#pragma unroll
            for (int m = 0; m < 4; ++m) { bf16_t* rowp = O + (size_t)(row0 + ai * HALF + m * 16) * ldc + col0;
#pragma unroll
                for (int bj = 0; bj < 2; ++bj) { f32x4 v0 = acc[ai][bj][m][0], v1 = acc[ai][bj][m][1];
                    if (ACT == 1) {
#pragma unroll
                        for (int e = 0; e < 4; ++e) { v0[e] = gelu_tanh(v0[e]); v1[e] = gelu_tanh(v1[e]); } }
                    if (ACT == 2) { v0 = v0 * 0.125f; v1 = v1 * 0.125f; }
                    if (ACT == 3) {
#pragma unroll
                        for (int e = 0; e < 4; ++e) { v0[e] = fast_sigmoid(v0[e]); v1[e] = fast_sigmoid(v1[e]); } }
                    if (ACT == 4) {
#pragma unroll
                        for (int e = 0; e < 4; ++e) { const float a = fmaxf(v0[e], 0.f), b = fmaxf(v1[e], 0.f); v0[e] = a * a; v1[e] = b * b; } }
                    u32x4 w; w.x = cvt_pk_bf16(v0[0], v0[1]); w.y = cvt_pk_bf16(v0[2], v0[3]); w.z = cvt_pk_bf16(v1[0], v1[1]); w.w = cvt_pk_bf16(v1[2], v1[3]);
                    *(u32x4*)(rowp + bj * HALF) = w; } }
    }
    __device__ __forceinline__ void operator()(const Acc& acc, const Unit& u, int wr, int wc, int fr, int fq) const {
        const int pn = u.pn;
        if (pn < 8) body<0>(acc, u, wr, wc, fr, fq);
        else if (pn < 16) body<1>(acc, u, wr, wc, fr, fq);
        else if (pn < 24) body<2>(acc, u, wr, wc, fr, fq);
        else if (pn < 26) body<0>(acc, u, wr, wc, fr, fq);
        else body<3>(acc, u, wr, wc, fr, fq);
    }
};
struct EpiFF1 {
    static constexpr bool HAS_MID = false; int mid_t;
    bf16_t* O; int ldc;
    __device__ __forceinline__ void operator()(const Acc& acc, const Unit& u, int wr, int wc, int fr, int fq) const {
        EpiProj e{0, O, ldc}; e.body<4>(acc, u, wr, wc, fr, fq);
    }
};
struct EpiRes {
    static constexpr bool HAS_MID = false; int mid_t;
    const float* base; float* out; const float* gate;
    __device__ __forceinline__ void operator()(const Acc& acc, const Unit& u, int wr, int wc, int fr, int fq) const {
        const int row0 = u.pm * BM + wr * 64 + fr, col0 = u.pn * BM + wc * 32 + 8 * fq;
        const float* gp = gate + (size_t)(u.pm >> 4) * NMOD + col0;
        f32x4 gv[2][2];
#pragma unroll
        for (int bj = 0; bj < 2; ++bj)
#pragma unroll
            for (int n = 0; n < 2; ++n) gv[bj][n] = *(const f32x4*)(gp + bj * HALF + 4 * n);
#pragma unroll
        for (int ai = 0; ai < 2; ++ai)
#pragma unroll
            for (int m = 0; m < 4; ++m) { const size_t off = (size_t)(row0 + ai * HALF + m * 16) * DM + col0;
#pragma unroll
                for (int bj = 0; bj < 2; ++bj)
#pragma unroll
                    for (int n = 0; n < 2; ++n) { const f32x4 bs = *(const f32x4*)(base + off + bj * HALF + 4 * n);
                        *(f32x4*)(out + off + bj * HALF + 4 * n) = bs + gv[bj][n] * acc[ai][bj][m][n]; }
                asm volatile("" ::: "memory"); }
    }
};
struct EpiMerge {
    static constexpr bool HAS_MID = true; int mid_t;
    const bf16_t* P; bf16_t* O;
    __device__ __forceinline__ void mid(Acc& acc, const Unit& u, int wr, int wc, int fr, int fq) const {
        int row0 = u.pm * BM + wr * 64 + fr, col0 = u.pn * BM + wc * 32 + 8 * fq;
        asm volatile("" : "+v"(row0), "+v"(col0));
#pragma unroll
        for (int ai = 0; ai < 2; ++ai)
#pragma unroll
            for (int m = 0; m < 4; ++m) { const bf16_t* rp = P + (size_t)(row0 + ai * HALF + m * 16) * INW + col0;
#pragma unroll
                for (int bj = 0; bj < 2; ++bj) { const u32x4 a = *(const u32x4*)(rp + C_GA + bj * HALF), b = *(const u32x4*)(rp + C_GB + bj * HALF);
#pragma unroll
                    for (int e = 0; e < 4; ++e) { const float r0 = bf_lo(a[e]) * __builtin_amdgcn_rcpf(fmaxf(bf_lo(b[e]), 1e-30f)), r1 = bf_hi(a[e]) * __builtin_amdgcn_rcpf(fmaxf(bf_hi(b[e]), 1e-30f));
                        acc[ai][bj][m][e >> 1][(e & 1) * 2] *= r0; acc[ai][bj][m][e >> 1][(e & 1) * 2 + 1] *= r1; } }
                asm volatile("" ::: "memory"); }
    }
    __device__ __forceinline__ void operator()(const Acc& acc, const Unit& u, int wr, int wc, int fr, int fq) const {
        const int row0 = u.pm * BM + wr * 64 + fr, col0 = u.pn * BM + wc * 32 + 8 * fq;
#pragma unroll
        for (int ai = 0; ai < 2; ++ai)
#pragma unroll
            for (int m = 0; m < 4; ++m) { const size_t row = (size_t)(row0 + ai * HALF + m * 16);
#pragma unroll
                for (int bj = 0; bj < 2; ++bj) { const u32x4 b = *(const u32x4*)(P + row * INW + C_GB + col0 + bj * HALF);
                    const f32x4 v0 = acc[ai][bj][m][0], v1 = acc[ai][bj][m][1];
                    u32x4 w; w.x = cvt_pk_bf16(v0[0] * bf_lo(b[0]), v0[1] * bf_hi(b[0])); w.y = cvt_pk_bf16(v0[2] * bf_lo(b[1]), v0[3] * bf_hi(b[1]));
                    w.z = cvt_pk_bf16(v1[0] * bf_lo(b[2]), v1[1] * bf_hi(b[2])); w.w = cvt_pk_bf16(v1[2] * bf_lo(b[3]), v1[3] * bf_hi(b[3]));
                    *(u32x4*)(O + row * DM + col0 + bj * HALF) = w; }
                asm volatile("" ::: "memory"); }
    }
};
}

__device__ __forceinline__ void phase_mod(const Params& p, unsigned char* lds, int tid, int lane, int wid, int G, int bid) {
    float* cs = (float*)lds;
    float* red = (float*)(lds + 65536);
    float* mod = (float*)(p.ws + WS_MOD);
    for (int item = bid; item < NMOD / 64; item += G) {
        for (int e = tid; e < NB * DM; e += 512) { const int b = e >> 11, k = e & 2047; const float v = p.c[e]; cs[k * 8 + b] = v * fast_sigmoid(v); }
        __syncthreads();
        const int col = item * 64 + lane;
        float acc[8];
#pragma unroll
        for (int b = 0; b < 8; ++b) acc[b] = 0.f;
        const float* W = p.w_ada + (size_t)(wid * 256) * NMOD + col;
#pragma unroll 8
        for (int k = 0; k < 256; ++k) {
            const float w = W[(size_t)k * NMOD];
            const f32x4 c0 = *(const f32x4*)(cs + (wid * 256 + k) * 8), c1 = *(const f32x4*)(cs + (wid * 256 + k) * 8 + 4);
            acc[0] += c0[0] * w; acc[1] += c0[1] * w; acc[2] += c0[2] * w; acc[3] += c0[3] * w;
            acc[4] += c1[0] * w; acc[5] += c1[1] * w; acc[6] += c1[2] * w; acc[7] += c1[3] * w;
        }
#pragma unroll
        for (int b = 0; b < 8; ++b) red[(wid * 8 + b) * 64 + lane] = acc[b];
        __syncthreads();
        { const int b = tid >> 6; float s = 0.f;
#pragma unroll
          for (int w = 0; w < 8; ++w) s += red[(w * 8 + b) * 64 + lane];
          mod[b * NMOD + col] = s + p.b_ada[col]; }
        __syncthreads();
    }
}
__device__ __forceinline__ void transpose_item(const float* W, int ldw, bf16_t* WT, int ldo, int koff, int nblk, int item, float* scr, int lane) {
    const int kb = item / nblk, nb = item - kb * nblk, k0 = 64 * kb, n0 = 32 * nb;
#pragma unroll 8
    for (int i = 0; i < 32; ++i) { const int kk = 2 * i + (lane >> 5); scr[kk * 33 + (lane & 31)] = W[(size_t)(k0 + kk) * ldw + n0 + (lane & 31)]; }
    asm volatile("s_waitcnt lgkmcnt(0)" ::: "memory");
    const int c = lane & 7;
#pragma unroll
    for (int j = 0; j < 4; ++j) { const int n = (lane >> 3) + 8 * j; const float* s = scr + (8 * c) * 33 + n;
        u32x4 o; o.x = cvt_pk_bf16(s[0 * 33], s[1 * 33]); o.y = cvt_pk_bf16(s[2 * 33], s[3 * 33]); o.z = cvt_pk_bf16(s[4 * 33], s[5 * 33]); o.w = cvt_pk_bf16(s[6 * 33], s[7 * 33]);
        *(u32x4*)(WT + (size_t)(n0 + n) * ldo + koff + k0 + 8 * c) = o; }
    asm volatile("s_waitcnt lgkmcnt(0)" ::: "memory");
}
__device__ __forceinline__ void phase_weights(const Params& p, unsigned char* lds, int lane, int wid, int G, int bid) {
    float* scr = (float*)(lds + wid * 16384);
    const int gw = bid * 8 + wid, NGW = G * 8;
    constexpr int I_IN = 32 * (INW / 32), I_SQ = 32 * 64, I_F1 = 32 * (DFF / 32), I_F2 = (DFF / 64) * 64, I_L = 32 * 4;
    constexpr int NITEMS = I_IN + 3 * I_SQ + I_F1 + I_F2 + 2 * I_L;
    for (int it = gw; it < NITEMS; it += NGW) {
        int r = it;
        if (r < I_IN) { transpose_item(p.w_in, INW, (bf16_t*)(p.ws + WS_WIN), DM, 0, INW / 32, r, scr, lane); continue; } r -= I_IN;
        if (r < I_SQ) { transpose_item(p.w_lru_out, DM, (bf16_t*)(p.ws + WS_WM), 4096, 0, 64, r, scr, lane); continue; } r -= I_SQ;
        if (r < I_SQ) { transpose_item(p.w_attn_out, DM, (bf16_t*)(p.ws + WS_WM), 4096, 2048, 64, r, scr, lane); continue; } r -= I_SQ;
        if (r < I_SQ) { transpose_item(p.w_out, DM, (bf16_t*)(p.ws + WS_WO), DM, 0, 64, r, scr, lane); continue; } r -= I_SQ;
        if (r < I_F1) { transpose_item(p.w_ff1, DFF, (bf16_t*)(p.ws + WS_W1), DM, 0, DFF / 32, r, scr, lane); continue; } r -= I_F1;
        if (r < I_F2) { transpose_item(p.w_ff2, DM, (bf16_t*)(p.ws + WS_W2), DFF, 0, 64, r, scr, lane); continue; } r -= I_F2;
        if (r < I_L) { transpose_item(p.lru_wa, 128, (bf16_t*)(p.ws + WS_WA), DM, 0, 4, r, scr, lane); continue; } r -= I_L;
        transpose_item(p.lru_wx, 128, (bf16_t*)(p.ws + WS_WX), DM, 0, 4, r, scr, lane);
    }
}
__device__ __forceinline__ void phase_norm_mod(const float* X, const float* g, const float* mod, int shift_off, int scale_off, bf16_t* H, int lane, int wid, int G, int bid) {
    const int gw = bid * 8 + wid, NGW = G * 8;
    for (int grp = gw; grp < MTOK / 16; grp += NGW) {
        const int row0 = grp * 16, b = row0 / SEQ;
        f32x4 cA[8], cB[8];
#pragma unroll
        for (int j = 0; j < 8; ++j) { const int col = 4 * lane + 256 * j; const f32x4 gg = *(const f32x4*)(g + col), sc = *(const f32x4*)(mod + (size_t)b * NMOD + scale_off + col);
            cA[j] = gg * (sc + 1.0f); cB[j] = *(const f32x4*)(mod + (size_t)b * NMOD + shift_off + col); }
        for (int r = 0; r < 16; ++r) {
            const float* xr = X + (size_t)(row0 + r) * DM + 4 * lane; f32x4 v[8]; float ss = 0.f;
#pragma unroll
            for (int j = 0; j < 8; ++j) { v[j] = *(const f32x4*)(xr + 256 * j); ss += (v[j][0] * v[j][0] + v[j][1] * v[j][1]) + (v[j][2] * v[j][2] + v[j][3] * v[j][3]); }
            const float rstd = rsqrtf(wave_sum(ss) * (1.0f / DM) + EPS);
            bf16_t* orow = H + (size_t)(row0 + r) * DM + 4 * lane;
#pragma unroll
            for (int j = 0; j < 8; ++j) { const f32x4 o = v[j] * rstd * cA[j] + cB[j]; u32x2 w; w.x = cvt_pk_bf16(o[0], o[1]); w.y = cvt_pk_bf16(o[2], o[3]); *(u32x2*)(orow + 256 * j) = w; }
        }
    }
}
__device__ __forceinline__ void phase_final_norm(float* X, const float* g, int lane, int wid, int G, int bid) {
    const int gw = bid * 8 + wid, NGW = G * 8;
    f32x4 cA[8];
#pragma unroll
    for (int j = 0; j < 8; ++j) cA[j] = *(const f32x4*)(g + 4 * lane + 256 * j);
    for (int row = gw; row < MTOK; row += NGW) {
        float* xr = X + (size_t)row * DM + 4 * lane; f32x4 v[8]; float ss = 0.f;
#pragma unroll
        for (int j = 0; j < 8; ++j) { v[j] = *(const f32x4*)(xr + 256 * j); ss += (v[j][0] * v[j][0] + v[j][1] * v[j][1]) + (v[j][2] * v[j][2] + v[j][3] * v[j][3]); }
        const float rstd = rsqrtf(wave_sum(ss) * (1.0f / DM) + EPS);
#pragma unroll
        for (int j = 0; j < 8; ++j) *(f32x4*)(xr + 256 * j) = v[j] * rstd * cA[j];
    }
}

__device__ __forceinline__ void phase_lru(const Params& p, unsigned char* lds, int tid, int lane, int wid, int G, int bid) {
    bf16_t* PROJ = (bf16_t*)(p.ws + WS_PROJ);
    const bf16_t* WaT = (const bf16_t*)(p.ws + WS_WA); const bf16_t* WxT = (const bf16_t*)(p.ws + WS_WX);
    unsigned char* XC = lds;
    float* AS = (float*)(lds + 69632);
    float* US = (float*)(lds + 102400);
    float* SEG = (float*)(lds + 135168);
    float* CAR = (float*)(lds + 139264);
    const int r32 = lane & 31, hi = lane >> 5;
    for (int item = bid; item < 512; item += G) {
        const int b = item >> 6, hblk = (item >> 2) & 15, jq = item & 3;
        const int cg8 = tid & 15, ts = tid >> 4;
        const int chbase = hblk * 128 + cg8 * 8;
        float cw[4][8], cb[8];
#pragma unroll
        for (int k = 0; k < 4; ++k) { const f32x4 a = *(const f32x4*)(p.conv_w + k * DM + chbase), bq = *(const f32x4*)(p.conv_w + k * DM + chbase + 4);
#pragma unroll
            for (int e = 0; e < 4; ++e) { cw[k][e] = a[e]; cw[k][4 + e] = bq[e]; } }
        { const f32x4 a = *(const f32x4*)(p.conv_b + chbase), bq = *(const f32x4*)(p.conv_b + chbase + 4);
#pragma unroll
          for (int e = 0; e < 4; ++e) { cb[e] = a[e]; cb[4 + e] = bq[e]; } }
        const size_t wofs = (size_t)(32 * jq + r32) * DM + hblk * 128 + 8 * hi;
        const int jj = hblk * 128 + 32 * jq + r32;
        const float ba = p.lru_ba[jj], bx = p.lru_bx[jj]; const float sp8 = 8.0f * log1pf(expf(-p.lru_lambda[jj]));
        if (tid < 32) CAR[tid] = 0.f;
        for (int c = 0; c < 16; ++c) {
            const int t0 = c * 256; const size_t tokbase = (size_t)b * SEQ + t0;
            u32x4 xr[11];
#pragma unroll
            for (int i = 0; i < 11; ++i) { const int tr = 8 * ts - 3 + i; xr[i] = (u32x4){0u, 0u, 0u, 0u};
                if (t0 + tr >= 0) xr[i] = *(const u32x4*)(PROJ + (size_t)((long)tokbase + tr) * INW + C_LX + chbase); }
#pragma unroll
            for (int tl = 0; tl < 8; ++tl) { float o[8];
#pragma unroll
                for (int e = 0; e < 8; ++e) o[e] = cb[e];
#pragma unroll
                for (int k = 0; k < 4; ++k) { const u32x4 w = xr[tl + k];
#pragma unroll
                    for (int e = 0; e < 4; ++e) { o[2 * e] += cw[k][2 * e] * bf_lo(w[e]); o[2 * e + 1] += cw[k][2 * e + 1] * bf_hi(w[e]); } }
                u32x4 w; w.x = cvt_pk_bf16(o[0], o[1]); w.y = cvt_pk_bf16(o[2], o[3]); w.z = cvt_pk_bf16(o[4], o[5]); w.w = cvt_pk_bf16(o[6], o[7]);
                *(u32x4*)(XC + (8 * ts + tl) * 272 + cg8 * 16) = w; }
            __syncthreads();
            f32x16 pa = {}, px = {};
            { const bf16_t* wap = WaT + wofs; const bf16_t* wxp = WxT + wofs; asm volatile("" : "+v"(wap), "+v"(wxp));
#pragma unroll
            for (int s = 0; s < 8; ++s) { const bf16x8 af = *(const bf16x8*)(XC + (32 * wid + r32) * 272 + (16 * s + 8 * hi) * 2);
                const bf16x8 fa = *(const bf16x8*)(wap + 16 * s), fx = *(const bf16x8*)(wxp + 16 * s);
                pa = __builtin_amdgcn_mfma_f32_32x32x16_bf16(af, fa, pa, 0, 0, 0); px = __builtin_amdgcn_mfma_f32_32x32x16_bf16(af, fx, px, 0, 0, 0); } }
#pragma unroll
            for (int reg = 0; reg < 16; ++reg) { const int t = 32 * wid + (reg & 3) + 8 * (reg >> 2) + 4 * hi;
                const float xcv = __uint_as_float(((unsigned)*(const bf16_t*)(XC + t * 272 + (32 * jq + r32) * 2)) << 16);
                const float rg = fast_sigmoid(pa[reg] + ba), ig = fast_sigmoid(px[reg] + bx);
                const float la = -sp8 * rg; const float a = __builtin_amdgcn_exp2f(LOG2E * la); const float e2 = 2.0f * la;
                const float m2 = (e2 > -0.03f) ? -(e2 * (1.0f + e2 * (0.5f + e2 * (0.16666667f + e2 * 0.041666668f)))) : (1.0f - a * a);
                float mult = sqrtf(m2); if (t0 + t == 0) mult = 1.0f;
                AS[t * 32 + r32] = a; US[t * 32 + r32] = mult * ig * xcv; }
            __syncthreads();
            { const int j = tid & 31, seg = tid >> 5; float A = 1.f, h = 0.f;
#pragma unroll
              for (int tt = 0; tt < 16; ++tt) { const int idx = (16 * seg + tt) * 32 + j; const float a = AS[idx], u = US[idx]; h = a * h + u; A *= a; }
              SEG[seg * 32 + j] = A; SEG[512 + seg * 32 + j] = h;
              __syncthreads();
              float hin = CAR[(c & 1) * 32 + j];
              for (int s2 = 0; s2 < seg; ++s2) hin = SEG[s2 * 32 + j] * hin + SEG[512 + s2 * 32 + j];
              h = hin;
#pragma unroll
              for (int tt = 0; tt < 16; ++tt) { const int idx = (16 * seg + tt) * 32 + j; h = AS[idx] * h + US[idx]; US[idx] = h; }
              if (seg == 15) CAR[((c + 1) & 1) * 32 + j] = h; }
            __syncthreads();
#pragma unroll
            for (int q = 0; q < 2; ++q) { const int idx = tid + 512 * q, t = idx >> 2, c8 = idx & 3;
                const f32x4 h0 = *(const f32x4*)(US + t * 32 + 8 * c8), h1 = *(const f32x4*)(US + t * 32 + 8 * c8 + 4);
                bf16_t* gp = PROJ + (tokbase + t) * INW + C_LG + hblk * 128 + 32 * jq + 8 * c8; const u32x4 gq = *(const u32x4*)gp;
                u32x4 w; w.x = cvt_pk_bf16(h0[0] * bf_lo(gq[0]), h0[1] * bf_hi(gq[0])); w.y = cvt_pk_bf16(h0[2] * bf_lo(gq[1]), h0[3] * bf_hi(gq[1]));
                w.z = cvt_pk_bf16(h1[0] * bf_lo(gq[2]), h1[1] * bf_hi(gq[2])); w.w = cvt_pk_bf16(h1[2] * bf_lo(gq[3]), h1[3] * bf_hi(gq[3]));
                *(u32x4*)gp = w; }
        }
        __syncthreads();
    }
}

__device__ __forceinline__ void phase_attn(const Params& p, unsigned char* lds, int tid, int lane, int wid, int G, int bid) {
    bf16_t* PROJ = (bf16_t*)(p.ws + WS_PROJ);
    unsigned char* KS = lds;
    unsigned char* VT = lds + 36864;
    float* BT = (float*)(lds + 70144);
    const int r32 = lane & 31, hi = lane >> 5;
    for (int u = bid; u < 1024; u += G) {
        const int hk = u & 3, n = (u >> 2) & 31, b = u >> 7;
#pragma unroll
        for (int q = 0; q < 4; ++q) { const int idx = tid + 512 * q, row = idx >> 3, ch = idx & 7; const int tok = 128 * (n - 1) + row;
            u32x4 kv = (u32x4){0u, 0u, 0u, 0u}, vv = kv;
            if (tok >= 0) { const bf16_t* base = PROJ + ((size_t)b * SEQ + tok) * INW; kv = *(const u32x4*)(base + C_K + hk * 64 + 8 * ch); vv = *(const u32x4*)(base + C_V + hk * 64 + 8 * ch); }
            *(u32x4*)(KS + row * 144 + ch * 16) = kv;
#pragma unroll
            for (int e = 0; e < 4; ++e) { *(bf16_t*)(VT + (8 * ch + 2 * e) * 520 + row * 2) = (bf16_t)(vv[e] & 0xffffu); *(bf16_t*)(VT + (8 * ch + 2 * e + 1) * 520 + row * 2) = (bf16_t)(vv[e] >> 16); } }
        for (int e = tid; e < 1536; e += 512) { const int g = e / 192, idx = e - g * 192, rel = idx - 32; float v = NEGF;
            if (rel >= 0 && rel < 128) { int bk = rel; if (rel >= 16) { bk = 16 + (int)(logf((float)rel * (1.0f / 16.0f)) / 2.0794415416798357f * 16.0f); bk = bk > 31 ? 31 : bk; }
                v = p.rel_bias[bk * 32 + hk * 8 + g]; }
            BT[e] = v; }
        __syncthreads();
        const int head = hk * 8 + wid; const float sink = p.attn_sinks[head];
        for (int i = 0; i < 4; ++i) {
            const size_t qtok = (size_t)b * SEQ + 128 * n + 32 * i + r32;
            bf16_t* qp = PROJ + qtok * INW + C_Q + head * 64;
            bf16x8 qf[4];
#pragma unroll
            for (int s = 0; s < 4; ++s) qf[s] = *(const bf16x8*)(qp + 16 * s + 8 * hi);
            f32x16 S[5];
#pragma unroll
            for (int dj = 0; dj < 5; ++dj) { f32x16 acc = {};
#pragma unroll
                for (int s = 0; s < 4; ++s) { const bf16x8 kf = *(const bf16x8*)(KS + (32 * (i + dj) + r32) * 144 + (16 * s + 8 * hi) * 2); acc = __builtin_amdgcn_mfma_f32_32x32x16_bf16(kf, qf[s], acc, 0, 0, 0); }
                S[dj] = acc; }
            float m = sink;
#pragma unroll
            for (int dj = 0; dj < 5; ++dj) { const bool dead = (n == 0) && (i + dj < 4);
#pragma unroll
                for (int reg = 0; reg < 16; ++reg) { const int kr = (reg & 3) + 8 * (reg >> 2) + 4 * hi; float v = S[dj][reg] + BT[wid * 192 + 160 - 32 * dj + r32 - kr]; v = dead ? NEGF : v; S[dj][reg] = v; m = fmaxf(m, v); } }
            m = fmaxf(m, __shfl_xor(m, 32));
            float l = 0.f; const float mb = m * LOG2E;
#pragma unroll
            for (int dj = 0; dj < 5; ++dj)
#pragma unroll
                for (int reg = 0; reg < 16; ++reg) { const float e = __builtin_amdgcn_exp2f(S[dj][reg] * LOG2E - mb); S[dj][reg] = e; l += e; }
            l += __shfl_xor(l, 32); l += __builtin_amdgcn_exp2f(sink * LOG2E - mb);
            const float inv = 1.0f / l;
            f32x16 O0 = {}, O1 = {};
#pragma unroll
            for (int dj = 0; dj < 5; ++dj)
#pragma unroll
                for (int ks = 0; ks < 2; ++ks) { u32x4 pw; pw.x = cvt_pk_bf16(S[dj][8 * ks + 0], S[dj][8 * ks + 1]); pw.y = cvt_pk_bf16(S[dj][8 * ks + 2], S[dj][8 * ks + 3]);
                    pw.z = cvt_pk_bf16(S[dj][8 * ks + 4], S[dj][8 * ks + 5]); pw.w = cvt_pk_bf16(S[dj][8 * ks + 6], S[dj][8 * ks + 7]);
                    const bf16x8 pf = __builtin_bit_cast(bf16x8, pw);
                    const unsigned char* vp = VT + r32 * 520 + (32 * (i + dj) + 16 * ks + 4 * hi) * 2;
                    { const u32x2 lo = *(const u32x2*)vp, h2 = *(const u32x2*)(vp + 16); const u32x4 vw = (u32x4){lo.x, lo.y, h2.x, h2.y};
                      O0 = __builtin_amdgcn_mfma_f32_32x32x16_bf16(__builtin_bit_cast(bf16x8, vw), pf, O0, 0, 0, 0); }
                    { const u32x2 lo = *(const u32x2*)(vp + 32 * 520), h2 = *(const u32x2*)(vp + 32 * 520 + 16); const u32x4 vw = (u32x4){lo.x, lo.y, h2.x, h2.y};
                      O1 = __builtin_amdgcn_mfma_f32_32x32x16_bf16(__builtin_bit_cast(bf16x8, vw), pf, O1, 0, 0, 0); } }
#pragma unroll
            for (int c4 = 0; c4 < 4; ++c4) { u32x2 w0, w1;
                w0.x = cvt_pk_bf16(O0[4 * c4] * inv, O0[4 * c4 + 1] * inv); w0.y = cvt_pk_bf16(O0[4 * c4 + 2] * inv, O0[4 * c4 + 3] * inv);
                w1.x = cvt_pk_bf16(O1[4 * c4] * inv, O1[4 * c4 + 1] * inv); w1.y = cvt_pk_bf16(O1[4 * c4 + 2] * inv, O1[4 * c4 + 3] * inv);
                *(u32x2*)(qp + 8 * c4 + 4 * hi) = w0; *(u32x2*)(qp + 32 + 8 * c4 + 4 * hi) = w1; }
        }
        __syncthreads();
    }
}

#ifndef PH_MASK
#define PH_MASK 0xFFFF
#endif
#define PH(k) if constexpr ((PH_MASK >> (k)) & 1)
__global__ void __launch_bounds__(512) fwd_megakernel(Params p) {
    extern __shared__ __attribute__((aligned(16))) unsigned char lds[];
    cg::grid_group grid = cg::this_grid();
    const int wid = __builtin_amdgcn_readfirstlane((int)threadIdx.x >> 6);
    const int G = gridDim.x, bid = blockIdx.x;
#define TIDS int tid = threadIdx.x; asm volatile("" : "+v"(tid)); const int lane = tid & 63; (void)lane;
    LAS unsigned char* lds3 = (LAS unsigned char*)lds;
    float* mod = (float*)(p.ws + WS_MOD);
    bf16_t* H = (bf16_t*)(p.ws + WS_H);
    bf16_t* PROJ = (bf16_t*)(p.ws + WS_PROJ);

    PH(0) { TIDS phase_mod(p, lds, tid, lane, wid, G, bid); }
    PH(1) { TIDS phase_weights(p, lds, lane, wid, G, bid); }
    grid.sync();
    PH(2) { TIDS phase_norm_mod(p.x, p.norm1_g, mod, 0, DM, H, lane, wid, G, bid); }
    grid.sync();
    PH(3) { pg8::Gemm g{H, (const bf16_t*)(p.ws + WS_WIN), MTOK, INW, DM, DM, DM}; pg8::StaticOrder S; S.init(MTOK, INW, G, bid);
      pg8::EpiProj E{0, PROJ, INW}; pg8::gemm_phase(lds3, g, S, E); }
    grid.sync();
    PH(4) { TIDS phase_lru(p, lds, tid, lane, wid, G, bid); }
    PH(5) { TIDS phase_attn(p, lds, tid, lane, wid, G, bid); }
    grid.sync();
    PH(6) { pg8::Gemm g{PROJ + C_LG, (const bf16_t*)(p.ws + WS_WM), MTOK, DM, 4096, INW, 4096}; pg8::StaticOrder S; S.init(MTOK, DM, G, bid);
      pg8::EpiMerge E{32, PROJ, H}; pg8::gemm_phase(lds3, g, S, E); }
    grid.sync();
    PH(7) { pg8::Gemm g{H, (const bf16_t*)(p.ws + WS_WO), MTOK, DM, DM, DM, DM}; pg8::StaticOrder S; S.init(MTOK, DM, G, bid);
      pg8::EpiRes E{0, p.x, p.out, mod + 2 * DM}; pg8::gemm_phase(lds3, g, S, E); }
    grid.sync();
    PH(8) { TIDS phase_norm_mod(p.out, p.norm2_g, mod, 3 * DM, 4 * DM, H, lane, wid, G, bid); }
    grid.sync();
    PH(9) { pg8::Gemm g{H, (const bf16_t*)(p.ws + WS_W1), MTOK, DFF, DM, DM, DM}; pg8::StaticOrder S; S.init(MTOK, DFF, G, bid);
      pg8::EpiFF1 E{0, PROJ, DFF}; pg8::gemm_phase(lds3, g, S, E); }
    grid.sync();
    PH(10) { pg8::Gemm g{PROJ, (const bf16_t*)(p.ws + WS_W2), MTOK, DM, DFF, DFF, DFF}; pg8::StaticOrder S; S.init(MTOK, DM, G, bid);
      pg8::EpiRes E{0, p.out, p.out, mod + 5 * DM}; pg8::gemm_phase(lds3, g, S, E); }
    grid.sync();
    PH(11) { TIDS phase_final_norm(p.out, p.final_g, lane, wid, G, bid); }
}

extern "C" void kernel_launch(void* const* d_in, const int* in_sizes, int n_in, void* d_out, int out_size, void* d_ws, size_t ws_size, hipStream_t stream) {
    static int grid_blocks = 0;
    if (grid_blocks == 0) {
        if (n_in != 22 || ws_size < WS_END || out_size != MTOK * DM) { fprintf(stderr, "kernel_launch: unexpected shapes (n_in %d, ws %zu need %zu, out %d)\n", n_in, ws_size, (size_t)WS_END, out_size); grid_blocks = -1; return; }
        int dev = 0, cus = 0, per_cu = 0;
        hipGetDevice(&dev);
        hipDeviceGetAttribute(&cus, hipDeviceAttributeMultiprocessorCount, dev);
        hipFuncSetAttribute((const void*)fwd_megakernel, hipFuncAttributeMaxDynamicSharedMemorySize, LDS_BYTES);
        hipOccupancyMaxActiveBlocksPerMultiprocessor(&per_cu, (const void*)fwd_megakernel, 512, LDS_BYTES);
        if (per_cu < 1) { fprintf(stderr, "kernel_launch: occupancy query says %d blocks/CU\n", per_cu); per_cu = 1; }
        grid_blocks = cus * per_cu;
    }
    if (grid_blocks < 0) return;
    Params p{};
    const float** pp = (const float**)&p;
    for (int i = 0; i < 22; ++i) pp[i] = (const float*)d_in[i];
    p.out = (float*)d_out; p.ws = (unsigned char*)d_ws;
    void* args[] = {&p};
    hipError_t e = hipLaunchCooperativeKernel((const void*)fwd_megakernel, dim3(grid_blocks), dim3(512), args, LDS_BYTES, stream);
    if (e != hipSuccess) fprintf(stderr, "cooperative launch failed: %s (grid %d)\n", hipGetErrorString(e), grid_blocks);
}
```

```cpp
#include <hip/hip_runtime.h>
#include <hip/hip_cooperative_groups.h>
#include <cstdio>
#include <cstdint>
namespace cg = cooperative_groups;

#define LAS __attribute__((address_space(3)))
typedef unsigned short bf16_t;
typedef short bf16x8 __attribute__((ext_vector_type(8)));
typedef float f32x4 __attribute__((ext_vector_type(4)));
typedef float f32x2 __attribute__((ext_vector_type(2)));
typedef float f32x16 __attribute__((ext_vector_type(16)));
typedef unsigned u32x4 __attribute__((ext_vector_type(4)));
typedef unsigned u32x2 __attribute__((ext_vector_type(2)));

constexpr int DM = 2048, NB = 8, SEQ = 4096, MTOK = NB * SEQ;
constexpr int INW = 10752, DFF = 8192, NMOD = 6 * DM;
constexpr int C_LX = 0, C_LG = 2048, C_Q = 4096, C_K = 6144, C_V = 6400, C_GA = 6656, C_GB = 8704;
constexpr float EPS = 1e-6f, NEGF = -1e30f, LOG2E = 1.4426950408889634f;

constexpr size_t WS_MOD = 0;
constexpr size_t WS_CTL = 512u << 10, CTL_BYTES = 16384;
constexpr size_t WS_WIN = 1u << 20;
constexpr size_t WS_WM = WS_WIN + (size_t)INW * DM * 2;
constexpr size_t WS_WO = WS_WM + (size_t)DM * 4096 * 2;
constexpr size_t WS_W1 = WS_WO + (size_t)DM * DM * 2;
constexpr size_t WS_W2 = WS_W1 + (size_t)DFF * DM * 2;
constexpr size_t WS_WA = WS_W2 + (size_t)DFF * DM * 2;
constexpr size_t WS_WX = WS_WA + (size_t)128 * DM * 2;
constexpr size_t WS_H = WS_WX + (size_t)128 * DM * 2;
constexpr size_t WS_PROJ = WS_H + (size_t)MTOK * DM * 2;
constexpr size_t WS_END = WS_PROJ + (size_t)MTOK * INW * 2;

constexpr int LDS_BYTES = 147456;

struct Params {
    const float *x, *c, *w_ada, *b_ada, *norm1_g, *w_in, *conv_w, *conv_b, *lru_wa, *lru_ba, *lru_wx, *lru_bx, *lru_lambda,
        *w_lru_out, *w_attn_out, *attn_sinks, *rel_bias, *w_out, *norm2_g, *w_ff1, *w_ff2, *final_g;
    float* out; unsigned char* ws;
};

__device__ __forceinline__ unsigned cvt_pk_bf16(float lo, float hi) { unsigned r; asm volatile("v_cvt_pk_bf16_f32 %0, %1, %2" : "=v"(r) : "v"(lo), "v"(hi)); return r; }
__device__ __forceinline__ float bf_lo(unsigned w) { return __uint_as_float(w << 16); }
__device__ __forceinline__ float bf_hi(unsigned w) { return __uint_as_float(w & 0xffff0000u); }
__device__ __forceinline__ float fast_sigmoid(float x) { return __builtin_amdgcn_rcpf(1.0f + __builtin_amdgcn_exp2f(-LOG2E * x)); }
__device__ __forceinline__ float gelu_tanh(float x) { const float u = x + 0.044715f * x * x * x; return x * __builtin_amdgcn_rcpf(1.0f + __builtin_amdgcn_exp2f(-2.3022082f * u)); }
__device__ __forceinline__ float wave_sum(float v) {
#pragma unroll
    for (int o = 1; o < 64; o <<= 1) v += __shfl_xor(v, o);
    return v;
}

namespace pg8 {
constexpr int BM = 256, BK = 64, HALF = 128, HTB = HALF * BK * 2, STAGE_BYTES = 8 * HTB, NXCD = 8, WGM = 8;
__host__ __device__ __forceinline__ int lds_byte(int r, int c) { const int st = (r >> 4) * 2 + (c >> 5), rr = r & 15, cc = c & 31, ob = rr * 64 + cc * 2; return st * 1024 + (ob ^ (((ob >> 9) & 1) << 5)); }
__host__ __device__ __forceinline__ void stage_rc(int b, int& R, int& C) { const int st = b / 1024, sb = b % 1024, swz = sb ^ (((sb >> 9) & 1) << 5); R = (st >> 1) * 16 + swz / 64; C = (st & 1) * 32 + (swz % 64) / 2; }
__host__ __device__ __forceinline__ int perm32(int rho) { const int n = rho >> 4, i = rho & 15; return 8 * (i >> 2) + 4 * n + (i & 3); }

struct Unit { int pm, pn; };
struct Gemm { const bf16_t* A; const bf16_t* Bt; int M, N, K, lda, ldb; };

struct StaticOrder {
    int nM, nN, nwg, G, c;
    __device__ void init(int M, int N, int G_, int c_) { nM = M / BM; nN = N / BM; nwg = nM * nN; G = G_; c = c_; }
    __device__ bool next(int i, Unit& u) const {
        const long L = (long)i * G + c; if (L >= nwg) return false;
        int wgid = (int)L; { const int q = nwg / NXCD, r = nwg % NXCD, xcd = wgid % NXCD, off = wgid / NXCD; wgid = (xcd < r ? xcd * (q + 1) : r * (q + 1) + (xcd - r) * q) + off; }
        const int nig = WGM * nN, gid = wgid / nig, fm = gid * WGM, gsz = (nM - fm) < WGM ? (nM - fm) : WGM;
        u.pm = fm + ((wgid % nig) % gsz); u.pn = (wgid % nig) / gsz; return true;
    }
};

template <class Epi>
__device__ __forceinline__ void gemm_phase(LAS unsigned char* lds, const Gemm g, const StaticOrder& S, const Epi& E) {
    int tid_ = threadIdx.x; asm volatile("" : "+v"(tid_));
    const int tid = tid_, wid = __builtin_amdgcn_readfirstlane(tid >> 6), lane = tid & 63, wr = wid >> 2, wc = wid & 3, fr = lane & 15, fq = lane >> 4;
    const int K = g.K, nt = K / BK;
    unsigned voffA[2], voffB[2];
#pragma unroll
    for (int i = 0; i < 2; ++i) { int R, C; stage_rc(tid * 16 + i * 8192, R, C); const int Rb = (R & ~31) + perm32(R & 31);
        voffA[i] = (unsigned)(R * g.lda + C) * 2u; voffB[i] = (unsigned)(Rb * g.ldb + C) * 2u; }
    const size_t kstep = (size_t)(BK * 2);
    const size_t hstepA = (size_t)HALF * g.lda * 2, hstepB = (size_t)HALF * g.ldb * 2;
    const size_t tstepA = 2 * hstepA, tstepB = 2 * hstepB;
    const unsigned ldsw = (unsigned)wid * 1024u;
    const int aoff = lds_byte(wr * 64 + fr, fq * 8), boff = lds_byte(wc * 32 + fr, fq * 8);
#define PG8_SA(b, h) (((b) * 2 + (h)) * HTB)
#define PG8_SB(b, h) ((4 + (b) * 2 + (h)) * HTB)
#define PG8_STAGE(bufoff, gbase, voff) do { _Pragma("unroll") for (int _i = 0; _i < 2; ++_i) \
        __builtin_amdgcn_global_load_lds((const unsigned*)((const char*)(gbase) + (voff)[_i]), (LAS unsigned*)(lds + (bufoff) + ldsw + _i * 8192), 16, 0, 0); } while (0)
#define PG8_LDA(dst, b, h) do { _Pragma("unroll") for (int m = 0; m < 4; ++m) _Pragma("unroll") for (int k = 0; k < 2; ++k) dst[m][k] = *(const LAS bf16x8*)(lds + PG8_SA(b, h) + aoff + m * 2048 + k * 1024); } while (0)
#define PG8_LDB(dst, b, h) do { _Pragma("unroll") for (int n = 0; n < 2; ++n) _Pragma("unroll") for (int k = 0; k < 2; ++k) dst[n][k] = *(const LAS bf16x8*)(lds + PG8_SB(b, h) + boff + n * 2048 + k * 1024); } while (0)
#define PG8_MMA(ai, bj, At, Bt) do { __builtin_amdgcn_s_setprio(1); _Pragma("unroll") for (int m = 0; m < 4; ++m) _Pragma("unroll") for (int n = 0; n < 2; ++n) _Pragma("unroll") for (int k = 0; k < 2; ++k) \
        acc[ai][bj][m][n] = __builtin_amdgcn_mfma_f32_16x16x32_bf16(Bt[n][k], At[m][k], acc[ai][bj][m][n], 0, 0, 0); __builtin_amdgcn_s_setprio(0); } while (0)
#define PG8_WAIT_V(n) asm volatile("s_waitcnt vmcnt(" #n ")" ::: "memory")
#define PG8_WAIT_L(n) asm volatile("s_waitcnt lgkmcnt(" #n ")" ::: "memory")
#define PG8_BAR __builtin_amdgcn_s_barrier()
#define PG8_SCHED __builtin_amdgcn_sched_barrier(0)
    Unit cur, nxt; int ui = 0;
    if (!S.next(0, cur)) return;
    f32x4 acc[2][2][4][2];
#pragma unroll
    for (int a = 0; a < 2; ++a)
#pragma unroll
        for (int b = 0; b < 2; ++b)
#pragma unroll
            for (int m = 0; m < 4; ++m)
#pragma unroll
                for (int n = 0; n < 2; ++n) acc[a][b][m][n] = (f32x4){0.f, 0.f, 0.f, 0.f};
    bf16x8 At[4][2], B0[2][2], B1[2][2];
    const char* cA = (const char*)g.A + (size_t)cur.pm * tstepA; const char* cB = (const char*)g.Bt + (size_t)cur.pn * tstepB;
    PG8_STAGE(PG8_SB(0, 0), cB, voffB); PG8_STAGE(PG8_SB(0, 1), cB + hstepB, voffB); PG8_STAGE(PG8_SA(0, 0), cA, voffA); PG8_STAGE(PG8_SA(0, 1), cA + hstepA, voffA);
    if (wr == 1) PG8_BAR;
    PG8_WAIT_V(2); PG8_BAR;
    PG8_STAGE(PG8_SB(1, 0), cB + kstep, voffB); PG8_STAGE(PG8_SA(1, 0), cA + kstep, voffA); PG8_STAGE(PG8_SB(1, 1), cB + hstepB + kstep, voffB);
    PG8_WAIT_V(6); PG8_BAR;
    for (;;) {
        const bool has_next = S.next(ui + 1, nxt);
        const char* nA = has_next ? (const char*)g.A + (size_t)nxt.pm * tstepA : cA; const char* nB = has_next ? (const char*)g.Bt + (size_t)nxt.pn * tstepB : cB;
        for (int t = 0; t < nt; t += 2) {
            if constexpr (Epi::HAS_MID) { if (t == E.mid_t) E.mid(acc, cur, wr, wc, fr, fq); }
            const bool last = (t == nt - 2);
            const char* a1 = cA + (size_t)(t + 1) * kstep;
            const char* a2 = last ? nA : cA + (size_t)(t + 2) * kstep; const char* b2 = last ? nB : cB + (size_t)(t + 2) * kstep;
            const char* a3 = a2 + kstep; const char* b3 = b2 + kstep;
            PG8_LDB(B0, 0, 0); PG8_LDB(B1, 0, 1); PG8_SCHED; PG8_LDA(At, 0, 0); PG8_STAGE(PG8_SA(1, 1), a1 + hstepA, voffA);
            PG8_WAIT_V(8); PG8_WAIT_L(0); PG8_BAR; PG8_MMA(0, 0, At, B0); PG8_MMA(0, 1, At, B1); PG8_BAR; PG8_SCHED;
            PG8_LDA(At, 0, 1); PG8_STAGE(PG8_SB(0, 0), b2, voffB); PG8_STAGE(PG8_SB(0, 1), b2 + hstepB, voffB); PG8_STAGE(PG8_SA(0, 0), a2, voffA);
            PG8_WAIT_V(8); PG8_WAIT_L(0); PG8_BAR; PG8_MMA(1, 0, At, B0); PG8_MMA(1, 1, At, B1); PG8_BAR; PG8_SCHED;
            PG8_LDB(B0, 1, 0); PG8_LDB(B1, 1, 1); PG8_SCHED; PG8_LDA(At, 1, 0); PG8_STAGE(PG8_SA(0, 1), a2 + hstepA, voffA);
            PG8_WAIT_V(8); PG8_WAIT_L(0); PG8_BAR; PG8_MMA(0, 0, At, B0); PG8_MMA(0, 1, At, B1); PG8_BAR; PG8_SCHED;
            PG8_LDA(At, 1, 1); PG8_STAGE(PG8_SB(1, 0), b3, voffB); PG8_STAGE(PG8_SB(1, 1), b3 + hstepB, voffB); PG8_STAGE(PG8_SA(1, 0), a3, voffA);
            PG8_WAIT_V(8); PG8_WAIT_L(0); PG8_BAR; PG8_MMA(1, 0, At, B0); PG8_MMA(1, 1, At, B1); PG8_BAR; PG8_SCHED;
        }
        if (wr == 0) PG8_BAR;
        E(acc, cur, wr, wc, fr, fq);
        if (!has_next) break;
#pragma unroll
        for (int a = 0; a < 2; ++a)
#pragma unroll
            for (int b = 0; b < 2; ++b)
#pragma unroll
                for (int m = 0; m < 4; ++m)
#pragma unroll
                    for (int n = 0; n < 2; ++n) acc[a][b][m][n] = (f32x4){0.f, 0.f, 0.f, 0.f};
        cur = nxt; cA = nA; cB = nB; ++ui;
        if (wr == 1) PG8_BAR;
    }
    PG8_WAIT_V(0);
    PG8_BAR;
#undef PG8_SA
#undef PG8_SB
#undef PG8_STAGE
#undef PG8_LDA
#undef PG8_LDB
#undef PG8_MMA
#undef PG8_WAIT_V
#undef PG8_WAIT_L
#undef PG8_BAR
#undef PG8_SCHED
}

typedef f32x4 Acc[2][2][4][2];

struct EpiProj {
    static constexpr bool HAS_MID = false; int mid_t;
    bf16_t* O; int ldc;
    template <int ACT> __device__ __forceinline__ void body(const Acc& acc, const Unit& u, int wr, int wc, int fr, int fq) const {
        const int row0 = u.pm * BM + wr * 64 + fr, col0 = u.pn * BM + wc * 32 + 8 * fq;
#pragma unroll
        for (int ai = 0; ai < 2; ++ai)
#pragma unroll
            for (int m = 0; m < 4; ++m) { bf16_t* rowp = O + (size_t)(row0 + ai * HALF + m * 16) * ldc + col0;
#pragma unroll
                for (int bj = 0; bj < 2; ++bj) { f32x4 v0 = acc[ai][bj][m][0], v1 = acc[ai][bj][m][1];
                    if (ACT == 1) {
#pragma unroll
                        for (int e = 0; e < 4; ++e) { v0[e] = gelu_tanh(v0[e]); v1[e] = gelu_tanh(v1[e]); } }
                    if (ACT == 2) { v0 = v0 * 0.125f; v1 = v1 * 0.125f; }
                    if (ACT == 3) {
#pragma unroll
                        for (int e = 0; e < 4; ++e) { v0[e] = fast_sigmoid(v0[e]); v1[e] = fast_sigmoid(v1[e]); } }
                    if (ACT == 4) {
#pragma unroll
                        for (int e = 0; e < 4; ++e) { const float a = fmaxf(v0[e], 0.f), b = fmaxf(v1[e], 0.f); v0[e] = a * a; v1[e] = b * b; } }
                    u32x4 w; w.x = cvt_pk_bf16(v0[0], v0[1]); w.y = cvt_pk_bf16(v0[2], v0[3]); w.z = cvt_pk_bf16(v1[0], v1[1]); w.w = cvt_pk_bf16(v1[2], v1[3]);
                    *(u32x4*)(rowp + bj * HALF) = w; } }
    }
    __device__ __forceinline__ void operator()(const Acc& acc, const Unit& u, int wr, int wc, int fr, int fq) const {
        const int pn = u.pn;
        if (pn < 8) body<0>(acc, u, wr, wc, fr, fq);
        else if (pn < 16) body<1>(acc, u, wr, wc, fr, fq);
        else if (pn < 24) body<2>(acc, u, wr, wc, fr, fq);
        else if (pn < 26) body<0>(acc, u, wr, wc, fr, fq);
        else body<3>(acc, u, wr, wc, fr, fq);
    }
};
struct EpiFF1 {
    static constexpr bool HAS_MID = false; int mid_t;
    bf16_t* O; int ldc;
    __device__ __forceinline__ void operator()(const Acc& acc, const Unit& u, int wr, int wc, int fr, int fq) const {
        EpiProj e{0, O, ldc}; e.body<4>(acc, u, wr, wc, fr, fq);
    }
};
struct EpiRes {
    static constexpr bool HAS_MID = false; int mid_t;
    const float* base; float* out; const float* gate;
    __device__ __forceinline__ void operator()(const Acc& acc, const Unit& u, int wr, int wc, int fr, int fq) const {
        const int row0 = u.pm * BM + wr * 64 + fr, col0 = u.pn * BM + wc * 32 + 8 * fq;
        const float* gp = gate + (size_t)(u.pm >> 4) * NMOD + col0;
        f32x4 gv[2][2];
#pragma unroll
        for (int bj = 0; bj < 2; ++bj)
#pragma unroll
            for (int n = 0; n < 2; ++n) gv[bj][n] = *(const f32x4*)(gp + bj * HALF + 4 * n);
#pragma unroll
        for (int ai = 0; ai < 2; ++ai)
#pragma unroll
            for (int m = 0; m < 4; ++m) { const size_t off = (size_t)(row0 + ai * HALF + m * 16) * DM + col0;
#pragma unroll
                for (int bj = 0; bj < 2; ++bj)
#pragma unroll
                    for (int n = 0; n < 2; ++n) { const f32x4 bs = *(const f32x4*)(base + off + bj * HALF + 4 * n);
                        *(f32x4*)(out + off + bj * HALF + 4 * n) = bs + gv[bj][n] * acc[ai][bj][m][n]; }
                asm volatile("" ::: "memory"); }
    }
};
struct EpiMerge {
    static constexpr bool HAS_MID = true; int mid_t;
    const bf16_t* P; bf16_t* O;
    __device__ __forceinline__ void mid(Acc& acc, const Unit& u, int wr, int wc, int fr, int fq) const {
        int row0 = u.pm * BM + wr * 64 + fr, col0 = u.pn * BM + wc * 32 + 8 * fq;
        asm volatile("" : "+v"(row0), "+v"(col0));
#pragma unroll
        for (int ai = 0; ai < 2; ++ai)
#pragma unroll
            for (int m = 0; m < 4; ++m) { const bf16_t* rp = P + (size_t)(row0 + ai * HALF + m * 16) * INW + col0;
#pragma unroll
                for (int bj = 0; bj < 2; ++bj) { const u32x4 a = *(const u32x4*)(rp + C_GA + bj * HALF), b = *(const u32x4*)(rp + C_GB + bj * HALF);
#pragma unroll
                    for (int e = 0; e < 4; ++e) { const float r0 = bf_lo(a[e]) * __builtin_amdgcn_rcpf(fmaxf(bf_lo(b[e]), 1e-30f)), r1 = bf_hi(a[e]) * __builtin_amdgcn_rcpf(fmaxf(bf_hi(b[e]), 1e-30f));
                        acc[ai][bj][m][e >> 1][(e & 1) * 2] *= r0; acc[ai][bj][m][e >> 1][(e & 1) * 2 + 1] *= r1; } }
                asm volatile("" ::: "memory"); }
    }
    __device__ __forceinline__ void operator()(const Acc& acc, const Unit& u, int wr, int wc, int fr, int fq) const {
        const int row0 = u.pm * BM + wr * 64 + fr, col0 = u.pn * BM + wc * 32 + 8 * fq;
#pragma unroll
        for (int ai = 0; ai < 2; ++ai)
#pragma unroll
            for (int m = 0; m < 4; ++m) { const size_t row = (size_t)(row0 + ai * HALF + m * 16);
#pragma unroll
                for (int bj = 0; bj < 2; ++bj) { const u32x4 b = *(const u32x4*)(P + row * INW + C_GB + col0 + bj * HALF);
                    const f32x4 v0 = acc[ai][bj][m][0], v1 = acc[ai][bj][m][1];
                    u32x4 w; w.x = cvt_pk_bf16(v0[0] * bf_lo(b[0]), v0[1] * bf_hi(b[0])); w.y = cvt_pk_bf16(v0[2] * bf_lo(b[1]), v0[3] * bf_hi(b[1]));
                    w.z = cvt_pk_bf16(v1[0] * bf_lo(b[2]), v1[1] * bf_hi(b[2])); w.w = cvt_pk_bf16(v1[2] * bf_lo(b[3]), v1[3] * bf_hi(b[3]));
                    *(u32x4*)(O + row * DM + col0 + bj * HALF) = w; }
                asm volatile("" ::: "memory"); }
    }
};
}

__device__ __forceinline__ void phase_mod(const Params& p, unsigned char* lds, int tid, int lane, int wid, int G, int bid) {
    float* cs = (float*)lds;
    float* red = (float*)(lds + 65536);
    float* mod = (float*)(p.ws + WS_MOD);
    for (int item = bid; item < NMOD / 64; item += G) {
        for (int e = tid; e < NB * DM; e += 512) { const int b = e >> 11, k = e & 2047; const float v = p.c[e]; cs[k * 8 + b] = v * fast_sigmoid(v); }
        __syncthreads();
        const int col = item * 64 + lane;
        float acc[8];
#pragma unroll
        for (int b = 0; b < 8; ++b) acc[b] = 0.f;
        const float* W = p.w_ada + (size_t)(wid * 256) * NMOD + col;
#pragma unroll 8
        for (int k = 0; k < 256; ++k) {
            const float w = W[(size_t)k * NMOD];
            const f32x4 c0 = *(const f32x4*)(cs + (wid * 256 + k) * 8), c1 = *(const f32x4*)(cs + (wid * 256 + k) * 8 + 4);
            acc[0] += c0[0] * w; acc[1] += c0[1] * w; acc[2] += c0[2] * w; acc[3] += c0[3] * w;
            acc[4] += c1[0] * w; acc[5] += c1[1] * w; acc[6] += c1[2] * w; acc[7] += c1[3] * w;
        }
#pragma unroll
        for (int b = 0; b < 8; ++b) red[(wid * 8 + b) * 64 + lane] = acc[b];
        __syncthreads();
        { const int b = tid >> 6; float s = 0.f;
#pragma unroll
          for (int w = 0; w < 8; ++w) s += red[(w * 8 + b) * 64 + lane];
          mod[b * NMOD + col] = s + p.b_ada[col]; }
        __syncthreads();
    }
}
__device__ __forceinline__ void transpose_item(const float* W, int ldw, bf16_t* WT, int ldo, int koff, int nblk, int item, float* scr, int lane) {
    const int kb = item / nblk, nb = item - kb * nblk, k0 = 64 * kb, n0 = 32 * nb;
    { const int kr = lane >> 3, nc = lane & 7; f32x4 v[8];
#pragma unroll
      for (int i = 0; i < 8; ++i) v[i] = *(const f32x4*)(W + (size_t)(k0 + 8 * i + kr) * ldw + n0 + 4 * nc);
#pragma unroll
      for (int i = 0; i < 8; ++i) { float* d = scr + (8 * i + kr) * 33 + 4 * nc; d[0] = v[i][0]; d[1] = v[i][1]; d[2] = v[i][2]; d[3] = v[i][3]; } }
    asm volatile("s_waitcnt lgkmcnt(0)" ::: "memory");
    const int c = lane & 7;
#pragma unroll
    for (int j = 0; j < 4; ++j) { const int n = (lane >> 3) + 8 * j; const float* s = scr + (8 * c) * 33 + n;
        u32x4 o; o.x = cvt_pk_bf16(s[0 * 33], s[1 * 33]); o.y = cvt_pk_bf16(s[2 * 33], s[3 * 33]); o.z = cvt_pk_bf16(s[4 * 33], s[5 * 33]); o.w = cvt_pk_bf16(s[6 * 33], s[7 * 33]);
        *(u32x4*)(WT + (size_t)(n0 + n) * ldo + koff + k0 + 8 * c) = o; }
    asm volatile("s_waitcnt lgkmcnt(0)" ::: "memory");
}
__device__ __forceinline__ void phase_weights(const Params& p, unsigned char* lds, int lane, int wid, int G, int bid) {
    float* scr = (float*)(lds + wid * 16384);
    const int gw = bid * 8 + wid, NGW = G * 8;
    constexpr int I_IN = 32 * (INW / 32), I_SQ = 32 * 64, I_F1 = 32 * (DFF / 32), I_F2 = (DFF / 64) * 64, I_L = 32 * 4;
    constexpr int NITEMS = I_IN + 3 * I_SQ + I_F1 + I_F2 + 2 * I_L;
    for (int it = gw; it < NITEMS; it += NGW) {
        int r = it;
        if (r < I_IN) { transpose_item(p.w_in, INW, (bf16_t*)(p.ws + WS_WIN), DM, 0, INW / 32, r, scr, lane); continue; } r -= I_IN;
        if (r < I_SQ) { transpose_item(p.w_lru_out, DM, (bf16_t*)(p.ws + WS_WM), 4096, 0, 64, r, scr, lane); continue; } r -= I_SQ;
        if (r < I_SQ) { transpose_item(p.w_attn_out, DM, (bf16_t*)(p.ws + WS_WM), 4096, 2048, 64, r, scr, lane); continue; } r -= I_SQ;
        if (r < I_SQ) { transpose_item(p.w_out, DM, (bf16_t*)(p.ws + WS_WO), DM, 0, 64, r, scr, lane); continue; } r -= I_SQ;
        if (r < I_F1) { transpose_item(p.w_ff1, DFF, (bf16_t*)(p.ws + WS_W1), DM, 0, DFF / 32, r, scr, lane); continue; } r -= I_F1;
        if (r < I_F2) { transpose_item(p.w_ff2, DM, (bf16_t*)(p.ws + WS_W2), DFF, 0, 64, r, scr, lane); continue; } r -= I_F2;
        if (r < I_L) { transpose_item(p.lru_wa, 128, (bf16_t*)(p.ws + WS_WA), DM, 0, 4, r, scr, lane); continue; } r -= I_L;
        transpose_item(p.lru_wx, 128, (bf16_t*)(p.ws + WS_WX), DM, 0, 4, r, scr, lane);
    }
}
__device__ __forceinline__ void phase_norm_mod(const float* X, const float* g, const float* mod, int shift_off, int scale_off, bf16_t* H, int lane, int wid, int G, int bid) {
    const int gw = bid * 8 + wid, NGW = G * 8;
    for (int grp = gw; grp < MTOK / 16; grp += NGW) {
        const int row0 = grp * 16, b = row0 / SEQ;
        f32x4 cA[8], cB[8];
#pragma unroll
        for (int j = 0; j < 8; ++j) { const int col = 4 * lane + 256 * j; const f32x4 gg = *(const f32x4*)(g + col), sc = *(const f32x4*)(mod + (size_t)b * NMOD + scale_off + col);
            cA[j] = gg * (sc + 1.0f); cB[j] = *(const f32x4*)(mod + (size_t)b * NMOD + shift_off + col); }
        for (int r = 0; r < 16; ++r) {
            const float* xr = X + (size_t)(row0 + r) * DM + 4 * lane; f32x4 v[8]; float ss = 0.f;
#pragma unroll
            for (int j = 0; j < 8; ++j) { v[j] = *(const f32x4*)(xr + 256 * j); ss += (v[j][0] * v[j][0] + v[j][1] * v[j][1]) + (v[j][2] * v[j][2] + v[j][3] * v[j][3]); }
            const float rstd = rsqrtf(wave_sum(ss) * (1.0f / DM) + EPS);
            bf16_t* orow = H + (size_t)(row0 + r) * DM + 4 * lane;
#pragma unroll
            for (int j = 0; j < 8; ++j) { const f32x4 o = v[j] * rstd * cA[j] + cB[j]; u32x2 w; w.x = cvt_pk_bf16(o[0], o[1]); w.y = cvt_pk_bf16(o[2], o[3]); *(u32x2*)(orow + 256 * j) = w; }
        }
    }
}
__device__ __forceinline__ void phase_final_norm(float* X, const float* g, int lane, int wid, int G, int bid) {
    const int gw = bid * 8 + wid, NGW = G * 8;
    f32x4 cA[8];
#pragma unroll
    for (int j = 0; j < 8; ++j) cA[j] = *(const f32x4*)(g + 4 * lane + 256 * j);
    for (int row = gw; row < MTOK; row += NGW) {
        float* xr = X + (size_t)row * DM + 4 * lane; f32x4 v[8]; float ss = 0.f;
#pragma unroll
        for (int j = 0; j < 8; ++j) { v[j] = *(const f32x4*)(xr + 256 * j); ss += (v[j][0] * v[j][0] + v[j][1] * v[j][1]) + (v[j][2] * v[j][2] + v[j][3] * v[j][3]); }
        const float rstd = rsqrtf(wave_sum(ss) * (1.0f / DM) + EPS);
#pragma unroll
        for (int j = 0; j < 8; ++j) *(f32x4*)(xr + 256 * j) = v[j] * rstd * cA[j];
    }
}

__device__ __forceinline__ void phase_lru(const Params& p, unsigned char* lds, int tid, int lane, int wid, int G, int bid) {
    bf16_t* PROJ = (bf16_t*)(p.ws + WS_PROJ);
    const bf16_t* WaT = (const bf16_t*)(p.ws + WS_WA); const bf16_t* WxT = (const bf16_t*)(p.ws + WS_WX);
    unsigned char* XC = lds;
    float* AS = (float*)(lds + 69632);
    float* US = (float*)(lds + 102400);
    float* SEG = (float*)(lds + 135168);
    float* CAR = (float*)(lds + 139264);
    const int r32 = lane & 31, hi = lane >> 5;
    for (int item = bid; item < 512; item += G) {
        const int b = item >> 6, hblk = (item >> 2) & 15, jq = item & 3;
        const int cg8 = tid & 15, ts = tid >> 4;
        const int chbase = hblk * 128 + cg8 * 8;
        const size_t wofs = (size_t)(32 * jq + r32) * DM + hblk * 128 + 8 * hi;
        const int jj = hblk * 128 + 32 * jq + r32;
        const float ba = p.lru_ba[jj], bx = p.lru_bx[jj]; const float sp8 = 8.0f * log1pf(expf(-p.lru_lambda[jj]));
        if (tid < 32) CAR[tid] = 0.f;
        for (int c = 0; c < 16; ++c) {
            const int t0 = c * 256; const size_t tokbase = (size_t)b * SEQ + t0;
            u32x4 xr[11];
#pragma unroll
            for (int i = 0; i < 11; ++i) { const int tr = 8 * ts - 3 + i; xr[i] = (u32x4){0u, 0u, 0u, 0u};
                if (t0 + tr >= 0) xr[i] = *(const u32x4*)(PROJ + (size_t)((long)tokbase + tr) * INW + C_LX + chbase); }
            float cw[4][8], cb[8];
            { const float* cwp = p.conv_w + chbase; const float* cbp = p.conv_b + chbase; asm volatile("" : "+v"(cwp), "+v"(cbp));
#pragma unroll
              for (int k = 0; k < 4; ++k) { const f32x4 a = *(const f32x4*)(cwp + k * DM), bq = *(const f32x4*)(cwp + k * DM + 4);
#pragma unroll
                  for (int e = 0; e < 4; ++e) { cw[k][e] = a[e]; cw[k][4 + e] = bq[e]; } }
              const f32x4 a = *(const f32x4*)(cbp), bq = *(const f32x4*)(cbp + 4);
#pragma unroll
              for (int e = 0; e < 4; ++e) { cb[e] = a[e]; cb[4 + e] = bq[e]; } }
            { float o[8][8];
#pragma unroll
              for (int i = 0; i < 11; ++i) { float xf[8];
#pragma unroll
                  for (int e = 0; e < 4; ++e) { xf[2 * e] = bf_lo(xr[i][e]); xf[2 * e + 1] = bf_hi(xr[i][e]); }
#pragma unroll
                  for (int k = 0; k < 4; ++k) { const int tl = i - k;
                      if (tl >= 0 && tl < 8) {
#pragma unroll
                          for (int e = 0; e < 8; ++e) o[tl][e] = (k == 0 ? cb[e] : o[tl][e]) + cw[k][e] * xf[e]; } }
                  if (i >= 3) { const int tl = i - 3;
                      u32x4 w; w.x = cvt_pk_bf16(o[tl][0], o[tl][1]); w.y = cvt_pk_bf16(o[tl][2], o[tl][3]); w.z = cvt_pk_bf16(o[tl][4], o[tl][5]); w.w = cvt_pk_bf16(o[tl][6], o[tl][7]);
                      *(u32x4*)(XC + (8 * ts + tl) * 272 + cg8 * 16) = w; }
                  __builtin_amdgcn_sched_barrier(0); } }
            __syncthreads();
            f32x16 pa = {}, px = {};
            { const bf16_t* wap = WaT + wofs; const bf16_t* wxp = WxT + wofs; asm volatile("" : "+v"(wap), "+v"(wxp));
#pragma unroll
            for (int s = 0; s < 8; ++s) { const bf16x8 af = *(const bf16x8*)(XC + (32 * wid + r32) * 272 + (16 * s + 8 * hi) * 2);
                const bf16x8 fa = *(const bf16x8*)(wap + 16 * s), fx = *(const bf16x8*)(wxp + 16 * s);
                pa = __builtin_amdgcn_mfma_f32_32x32x16_bf16(af, fa, pa, 0, 0, 0); px = __builtin_amdgcn_mfma_f32_32x32x16_bf16(af, fx, px, 0, 0, 0); } }
#pragma unroll
            for (int reg = 0; reg < 16; ++reg) { const int t = 32 * wid + (reg & 3) + 8 * (reg >> 2) + 4 * hi;
                const float xcv = __uint_as_float(((unsigned)*(const bf16_t*)(XC + t * 272 + (32 * jq + r32) * 2)) << 16);
                const float rg = fast_sigmoid(pa[reg] + ba), ig = fast_sigmoid(px[reg] + bx);
                const float la = -sp8 * rg; const float a = __builtin_amdgcn_exp2f(LOG2E * la); const float e2 = 2.0f * la;
                const float m2 = (e2 > -0.03f) ? -(e2 * (1.0f + e2 * (0.5f + e2 * (0.16666667f + e2 * 0.041666668f)))) : (1.0f - a * a);
                float mult = sqrtf(m2); if (t0 + t == 0) mult = 1.0f;
                AS[t * 32 + r32] = a; US[t * 32 + r32] = mult * ig * xcv;
                if ((reg & 3) == 3) __builtin_amdgcn_sched_barrier(0); }
            __syncthreads();
            u32x4 gq2[2];
#pragma unroll
            for (int q = 0; q < 2; ++q) { const int idx = tid + 512 * q, t = idx >> 2, c8 = idx & 3; gq2[q] = *(const u32x4*)(PROJ + (tokbase + t) * INW + C_LG + hblk * 128 + 32 * jq + 8 * c8); }
            { const int j = tid & 31, seg = tid >> 5; float A = 1.f, h = 0.f;
#pragma unroll
              for (int tt = 0; tt < 16; ++tt) { const int idx = (16 * seg + tt) * 32 + j; const float a = AS[idx], u = US[idx]; h = a * h + u; A *= a; }
              SEG[seg * 32 + j] = A; SEG[512 + seg * 32 + j] = h;
              __syncthreads();
              float hin = CAR[(c & 1) * 32 + j];
              for (int s2 = 0; s2 < seg; ++s2) hin = SEG[s2 * 32 + j] * hin + SEG[512 + s2 * 32 + j];
              h = hin;
#pragma unroll
              for (int tt = 0; tt < 16; ++tt) { const int idx = (16 * seg + tt) * 32 + j; h = AS[idx] * h + US[idx]; US[idx] = h; }
              if (seg == 15) CAR[((c + 1) & 1) * 32 + j] = h; }
            __syncthreads();
#pragma unroll
            for (int q = 0; q < 2; ++q) { const int idx = tid + 512 * q, t = idx >> 2, c8 = idx & 3;
                const f32x4 h0 = *(const f32x4*)(US + t * 32 + 8 * c8), h1 = *(const f32x4*)(US + t * 32 + 8 * c8 + 4);
                bf16_t* gp = PROJ + (tokbase + t) * INW + C_LG + hblk * 128 + 32 * jq + 8 * c8; const u32x4 gq = gq2[q];
                u32x4 w; w.x = cvt_pk_bf16(h0[0] * bf_lo(gq[0]), h0[1] * bf_hi(gq[0])); w.y = cvt_pk_bf16(h0[2] * bf_lo(gq[1]), h0[3] * bf_hi(gq[1]));
                w.z = cvt_pk_bf16(h1[0] * bf_lo(gq[2]), h1[1] * bf_hi(gq[2])); w.w = cvt_pk_bf16(h1[2] * bf_lo(gq[3]), h1[3] * bf_hi(gq[3]));
                *(u32x4*)gp = w; }
        }
        __syncthreads();
    }
}

__device__ __forceinline__ void phase_attn(const Params& p, unsigned char* lds, int tid, int lane, int wid, int G, int bid) {
    bf16_t* PROJ = (bf16_t*)(p.ws + WS_PROJ);
    unsigned char* KS = lds;
    unsigned char* VT = lds + 36864;
    float* BT = (float*)(lds + 70144);
    const int r32 = lane & 31, hi = lane >> 5;
    for (int u = bid; u < 1024; u += G) {
        const int hk = u & 3, n = (u >> 2) & 31, b = u >> 7;
#pragma unroll
        for (int q = 0; q < 4; ++q) { const int idx = tid + 512 * q, row = idx >> 3, ch = idx & 7; const int tok = 128 * (n - 1) + row;
            u32x4 kv = (u32x4){0u, 0u, 0u, 0u}, vv = kv;
            if (tok >= 0) { const bf16_t* base = PROJ + ((size_t)b * SEQ + tok) * INW; kv = *(const u32x4*)(base + C_K + hk * 64 + 8 * ch); vv = *(const u32x4*)(base + C_V + hk * 64 + 8 * ch); }
            *(u32x4*)(KS + row * 144 + ch * 16) = kv;
#pragma unroll
            for (int e = 0; e < 4; ++e) { *(bf16_t*)(VT + (8 * ch + 2 * e) * 520 + row * 2) = (bf16_t)(vv[e] & 0xffffu); *(bf16_t*)(VT + (8 * ch + 2 * e + 1) * 520 + row * 2) = (bf16_t)(vv[e] >> 16); } }
        for (int e = tid; e < 1536; e += 512) { const int g = e / 192, idx = e - g * 192, rel = idx - 32; float v = NEGF;
            if (rel >= 0 && rel < 128) { int bk = rel; if (rel >= 16) { bk = 16 + (int)(logf((float)rel * (1.0f / 16.0f)) / 2.0794415416798357f * 16.0f); bk = bk > 31 ? 31 : bk; }
                v = p.rel_bias[bk * 32 + hk * 8 + g]; }
            BT[e] = v; }
        __syncthreads();
        const int head = hk * 8 + wid; const float sink = p.attn_sinks[head];
        for (int i = 0; i < 4; ++i) {
            const size_t qtok = (size_t)b * SEQ + 128 * n + 32 * i + r32;
            bf16_t* qp = PROJ + qtok * INW + C_Q + head * 64;
            bf16x8 qf[4];
#pragma unroll
            for (int s = 0; s < 4; ++s) qf[s] = *(const bf16x8*)(qp + 16 * s + 8 * hi);
            f32x16 S[5];
#pragma unroll
            for (int dj = 0; dj < 5; ++dj) { f32x16 acc = {};
#pragma unroll
                for (int s = 0; s < 4; ++s) { const bf16x8 kf = *(const bf16x8*)(KS + (32 * (i + dj) + r32) * 144 + (16 * s + 8 * hi) * 2); acc = __builtin_amdgcn_mfma_f32_32x32x16_bf16(kf, qf[s], acc, 0, 0, 0); }
                S[dj] = acc; }
            float m = sink;
#pragma unroll
            for (int dj = 0; dj < 5; ++dj) { const bool dead = (n == 0) && (i + dj < 4);
#pragma unroll
                for (int reg = 0; reg < 16; ++reg) { const int kr = (reg & 3) + 8 * (reg >> 2) + 4 * hi; float v = S[dj][reg] + BT[wid * 192 + 160 - 32 * dj + r32 - kr]; v = dead ? NEGF : v; S[dj][reg] = v; m = fmaxf(m, v); } }
            m = fmaxf(m, __shfl_xor(m, 32));
            float l = 0.f; const float mb = m * LOG2E;
#pragma unroll
            for (int dj = 0; dj < 5; ++dj)
#pragma unroll
                for (int reg = 0; reg < 16; ++reg) { const float e = __builtin_amdgcn_exp2f(S[dj][reg] * LOG2E - mb); S[dj][reg] = e; l += e; }
            l += __shfl_xor(l, 32); l += __builtin_amdgcn_exp2f(sink * LOG2E - mb);
            const float inv = 1.0f / l;
            f32x16 O0 = {}, O1 = {};
#pragma unroll
            for (int dj = 0; dj < 5; ++dj)
#pragma unroll
                for (int ks = 0; ks < 2; ++ks) { u32x4 pw; pw.x = cvt_pk_bf16(S[dj][8 * ks + 0], S[dj][8 * ks + 1]); pw.y = cvt_pk_bf16(S[dj][8 * ks + 2], S[dj][8 * ks + 3]);
                    pw.z = cvt_pk_bf16(S[dj][8 * ks + 4], S[dj][8 * ks + 5]); pw.w = cvt_pk_bf16(S[dj][8 * ks + 6], S[dj][8 * ks + 7]);
                    const bf16x8 pf = __builtin_bit_cast(bf16x8, pw);
                    const unsigned char* vp = VT + r32 * 520 + (32 * (i + dj) + 16 * ks + 4 * hi) * 2;
                    { const u32x2 lo = *(const u32x2*)vp, h2 = *(const u32x2*)(vp + 16); const u32x4 vw = (u32x4){lo.x, lo.y, h2.x, h2.y};
                      O0 = __builtin_amdgcn_mfma_f32_32x32x16_bf16(__builtin_bit_cast(bf16x8, vw), pf, O0, 0, 0, 0); }
                    { const u32x2 lo = *(const u32x2*)(vp + 32 * 520), h2 = *(const u32x2*)(vp + 32 * 520 + 16); const u32x4 vw = (u32x4){lo.x, lo.y, h2.x, h2.y};
                      O1 = __builtin_amdgcn_mfma_f32_32x32x16_bf16(__builtin_bit_cast(bf16x8, vw), pf, O1, 0, 0, 0); } }
#pragma unroll
            for (int c4 = 0; c4 < 4; ++c4) { u32x2 w0, w1;
                w0.x = cvt_pk_bf16(O0[4 * c4] * inv, O0[4 * c4 + 1] * inv); w0.y = cvt_pk_bf16(O0[4 * c4 + 2] * inv, O0[4 * c4 + 3] * inv);
                w1.x = cvt_pk_bf16(O1[4 * c4] * inv, O1[4 * c4 + 1] * inv); w1.y = cvt_pk_bf16(O1[4 * c4 + 2] * inv, O1[4 * c4 + 3] * inv);
                *(u32x2*)(qp + 8 * c4 + 4 * hi) = w0; *(u32x2*)(qp + 32 + 8 * c4 + 4 * hi) = w1; }
        }
        __syncthreads();
    }
}


#define XB_TMO      128
#define XB_XCNT(j)  (256  + 64 * (j))
#define XB_XSUB(j)  (1280 + 64 * (j))
#define XB_XGEN(j)  (2304 + 64 * (j))
#define XB_TOP      3328
#define XB_TOPGEN   3392
#define XCD_BAR_WORDS 3456
#define XB_SPIN_CAP (1u << 22)
__device__ __forceinline__ unsigned xb_ld(unsigned* p)              { return __hip_atomic_load(p, __ATOMIC_RELAXED, __HIP_MEMORY_SCOPE_AGENT); }
__device__ __forceinline__ unsigned xb_add(unsigned* p, unsigned v) { return __hip_atomic_fetch_add(p, v, __ATOMIC_RELAXED, __HIP_MEMORY_SCOPE_AGENT); }
__device__ __forceinline__ unsigned xb_xcc_id() { return (unsigned)__builtin_amdgcn_s_getreg((3 << 11) | 20) & 0xFu; }
#define XB_SPIN(cond, bar) do { unsigned _sp = 0; while (cond) { __builtin_amdgcn_s_sleep(1); \
    if ((++_sp & 255u) == 0u) { if (xb_ld(&(bar)[XB_TMO])) break; if (_sp > XB_SPIN_CAP) { atomicAdd(&(bar)[XB_TMO], 1u); break; } } } } while (0)
struct XcdBarrier { unsigned* bar; unsigned x; volatile LAS unsigned* st; };
__device__ __forceinline__ XcdBarrier xcd_barrier_post(unsigned* bar, volatile LAS unsigned* st) {
    XcdBarrier b; b.bar = bar; b.x = xb_xcc_id(); b.st = st;
    if (threadIdx.x == 0) (void)xb_add(&bar[XB_XCNT(b.x)], 1u);
    return b;
}
__device__ __forceinline__ void xcd_barrier_complete(unsigned* bar, unsigned x, unsigned& nloc, unsigned& nx) {
    const unsigned G = gridDim.x * gridDim.y * gridDim.z;
    unsigned sum, cnt, mine, sp = 0u;
    for (;;) {
        sum = 0u; cnt = 0u; mine = 0u;
#pragma unroll
        for (unsigned j = 0; j < 16; ++j) { const unsigned c = xb_ld(&bar[XB_XCNT(j)]); sum += c; cnt += (c > 0u) ? 1u : 0u; mine = (j == x) ? c : mine; }
        if (sum == G) break;
        __builtin_amdgcn_s_sleep(1);
        if ((++sp & 255u) == 0u) { if (xb_ld(&bar[XB_TMO])) break; if (sp > XB_SPIN_CAP) { atomicAdd(&bar[XB_TMO], 1u); break; } }
    }
    nloc = mine > 0u ? mine : 1u; nx = cnt > 0u ? cnt : 1u;
}
__device__ __forceinline__ void xcd_barrier(const XcdBarrier& b) {
    asm volatile("s_waitcnt vmcnt(0)" ::: "memory");
    __syncthreads();
    if (threadIdx.x == 0) {
        unsigned* bar = b.bar;
        __builtin_amdgcn_s_waitcnt(0);
        unsigned nloc = b.st[0], nx = b.st[1];
        if (nloc == 0u) { xcd_barrier_complete(bar, b.x, nloc, nx); b.st[0] = nloc; b.st[1] = nx; }
        const unsigned old = xb_add(&bar[XB_XSUB(b.x)], 1u);
        const unsigned gen = old / nloc;
        if (old + 1u == (gen + 1u) * nloc) {
            __builtin_amdgcn_fence(__ATOMIC_RELEASE, "agent");
            asm volatile("s_waitcnt vmcnt(0)" ::: "memory");
            const unsigned og = xb_add(&bar[XB_TOP], 1u);
            const unsigned tg = og / nx;
            if (og + 1u == (tg + 1u) * nx) xb_add(&bar[XB_TOPGEN], 1u);
            else XB_SPIN(xb_ld(&bar[XB_TOPGEN]) == tg, bar);
            __builtin_amdgcn_fence(__ATOMIC_ACQUIRE, "agent");
            xb_add(&bar[XB_XGEN(b.x)], 1u);
            asm volatile("s_waitcnt vmcnt(0)" ::: "memory");
        } else {
            XB_SPIN(xb_ld(&bar[XB_XGEN(b.x)]) == gen, bar);
            __builtin_amdgcn_fence(__ATOMIC_ACQUIRE, "agent");
            asm volatile("s_waitcnt vmcnt(0)" ::: "memory");
        }
    }
    __syncthreads();
}

#ifndef PH_MASK
#define PH_MASK 0xFFFF
#endif
#define PH(k) if constexpr ((PH_MASK >> (k)) & 1)
__global__ void __launch_bounds__(512) fwd_megakernel(Params p) {
    extern __shared__ __attribute__((aligned(16))) unsigned char lds[];
    cg::grid_group grid = cg::this_grid();
    const int wid = __builtin_amdgcn_readfirstlane((int)threadIdx.x >> 6);
    const int G = gridDim.x, bid = blockIdx.x;
#define TIDS int tid = threadIdx.x; asm volatile("" : "+v"(tid)); const int lane = tid & 63; (void)lane;
    LAS unsigned char* lds3 = (LAS unsigned char*)lds;
    float* mod = (float*)(p.ws + WS_MOD);
    bf16_t* H = (bf16_t*)(p.ws + WS_H);
    bf16_t* PROJ = (bf16_t*)(p.ws + WS_PROJ);
    volatile LAS unsigned* bst = (volatile LAS unsigned*)(lds3 + LDS_BYTES - 64);
    if (threadIdx.x < 2) bst[threadIdx.x] = 0u;
    __syncthreads();
    const XcdBarrier xbar = xcd_barrier_post((unsigned*)(p.ws + WS_CTL), bst);
    if (p.ws == nullptr) grid.sync();
#define GRID_SYNC() xcd_barrier(xbar)

    PH(0) { TIDS phase_mod(p, lds, tid, lane, wid, G, bid); }
    PH(1) { TIDS phase_weights(p, lds, lane, wid, G, bid); }
    GRID_SYNC();
    PH(2) { TIDS phase_norm_mod(p.x, p.norm1_g, mod, 0, DM, H, lane, wid, G, bid); }
    GRID_SYNC();
    PH(3) { pg8::Gemm g{H, (const bf16_t*)(p.ws + WS_WIN), MTOK, INW, DM, DM, DM}; pg8::StaticOrder S; S.init(MTOK, INW, G, bid);
      pg8::EpiProj E{0, PROJ, INW}; pg8::gemm_phase(lds3, g, S, E); }
    GRID_SYNC();
    PH(4) { TIDS phase_lru(p, lds, tid, lane, wid, G, bid); }
    PH(5) { TIDS phase_attn(p, lds, tid, lane, wid, G, bid); }
    GRID_SYNC();
    PH(6) { pg8::Gemm g{PROJ + C_LG, (const bf16_t*)(p.ws + WS_WM), MTOK, DM, 4096, INW, 4096}; pg8::StaticOrder S; S.init(MTOK, DM, G, bid);
      pg8::EpiMerge E{32, PROJ, H}; pg8::gemm_phase(lds3, g, S, E); }
    GRID_SYNC();
    PH(7) { pg8::Gemm g{H, (const bf16_t*)(p.ws + WS_WO), MTOK, DM, DM, DM, DM}; pg8::StaticOrder S; S.init(MTOK, DM, G, bid);
      pg8::EpiRes E{0, p.x, p.out, mod + 2 * DM}; pg8::gemm_phase(lds3, g, S, E); }
    GRID_SYNC();
    PH(8) { TIDS phase_norm_mod(p.out, p.norm2_g, mod, 3 * DM, 4 * DM, H, lane, wid, G, bid); }
    GRID_SYNC();
    PH(9) { pg8::Gemm g{H, (const bf16_t*)(p.ws + WS_W1), MTOK, DFF, DM, DM, DM}; pg8::StaticOrder S; S.init(MTOK, DFF, G, bid);
      pg8::EpiFF1 E{0, PROJ, DFF}; pg8::gemm_phase(lds3, g, S, E); }
    GRID_SYNC();
    PH(10) { pg8::Gemm g{PROJ, (const bf16_t*)(p.ws + WS_W2), MTOK, DM, DFF, DFF, DFF}; pg8::StaticOrder S; S.init(MTOK, DM, G, bid);
      pg8::EpiRes E{0, p.out, p.out, mod + 5 * DM}; pg8::gemm_phase(lds3, g, S, E); }
    GRID_SYNC();
    PH(11) { TIDS phase_final_norm(p.out, p.final_g, lane, wid, G, bid); }
}

extern "C" void kernel_launch(void* const* d_in, const int* in_sizes, int n_in, void* d_out, int out_size, void* d_ws, size_t ws_size, hipStream_t stream) {
    static int grid_blocks = 0;
    if (grid_blocks == 0) {
        if (n_in != 22 || ws_size < WS_END || out_size != MTOK * DM) { fprintf(stderr, "kernel_launch: unexpected shapes (n_in %d, ws %zu need %zu, out %d)\n", n_in, ws_size, (size_t)WS_END, out_size); grid_blocks = -1; return; }
        int dev = 0, cus = 0, per_cu = 0;
        hipGetDevice(&dev);
        hipDeviceGetAttribute(&cus, hipDeviceAttributeMultiprocessorCount, dev);
        hipFuncSetAttribute((const void*)fwd_megakernel, hipFuncAttributeMaxDynamicSharedMemorySize, LDS_BYTES);
        hipOccupancyMaxActiveBlocksPerMultiprocessor(&per_cu, (const void*)fwd_megakernel, 512, LDS_BYTES);
        if (per_cu < 1) { fprintf(stderr, "kernel_launch: occupancy query says %d blocks/CU\n", per_cu); per_cu = 1; }
        grid_blocks = cus * per_cu;
    }
    if (grid_blocks < 0) return;
    Params p{};
    const float** pp = (const float**)&p;
    for (int i = 0; i < 22; ++i) pp[i] = (const float*)d_in[i];
    p.out = (float*)d_out; p.ws = (unsigned char*)d_ws;
    if (hipMemsetAsync((unsigned char*)d_ws + WS_CTL, 0, CTL_BYTES, stream) != hipSuccess) { fprintf(stderr, "kernel_launch: memset of barrier words failed\n"); return; }
    void* args[] = {&p};
    hipError_t e = hipLaunchCooperativeKernel((const void*)fwd_megakernel, dim3(grid_blocks), dim3(512), args, LDS_BYTES, stream);
    if (e != hipSuccess) fprintf(stderr, "cooperative launch failed: %s (grid %d)\n", hipGetErrorString(e), grid_blocks);
}
```

```cpp
#include <hip/hip_runtime.h>
#include <hip/hip_cooperative_groups.h>
#include <cstdio>
#include <cstdint>
namespace cg = cooperative_groups;

#define LAS __attribute__((address_space(3)))
typedef unsigned short bf16_t;
typedef short bf16x8 __attribute__((ext_vector_type(8)));
typedef float f32x4 __attribute__((ext_vector_type(4)));
typedef float f32x2 __attribute__((ext_vector_type(2)));
typedef float f32x16 __attribute__((ext_vector_type(16)));
typedef unsigned u32x4 __attribute__((ext_vector_type(4)));
typedef unsigned u32x2 __attribute__((ext_vector_type(2)));

constexpr int DM = 2048, NB = 8, SEQ = 4096, MTOK = NB * SEQ;
constexpr int INW = 10752, DFF = 8192, NMOD = 6 * DM;
constexpr int C_LX = 0, C_LG = 2048, C_Q = 4096, C_K = 6144, C_V = 6400, C_GA = 6656, C_GB = 8704;
constexpr float EPS = 1e-6f, NEGF = -1e30f, LOG2E = 1.4426950408889634f;

constexpr size_t WS_MOD = 0;
constexpr size_t WS_CTL = 512u << 10, CTL_BYTES = 16384;
constexpr size_t WS_WIN = 1u << 20;
constexpr size_t WS_WM = WS_WIN + (size_t)INW * DM * 2;
constexpr size_t WS_WO = WS_WM + (size_t)DM * 4096 * 2;
constexpr size_t WS_W1 = WS_WO + (size_t)DM * DM * 2;
constexpr size_t WS_W2 = WS_W1 + (size_t)DFF * DM * 2;
constexpr size_t WS_WA = WS_W2 + (size_t)DFF * DM * 2;
constexpr size_t WS_WX = WS_WA + (size_t)128 * DM * 2;
constexpr size_t WS_H = WS_WX + (size_t)128 * DM * 2;
constexpr size_t WS_PROJ = WS_H + (size_t)MTOK * DM * 2;
constexpr size_t WS_END = WS_PROJ + (size_t)MTOK * INW * 2;

constexpr int LDS_BYTES = 163840;

struct Params {
    const float *x, *c, *w_ada, *b_ada, *norm1_g, *w_in, *conv_w, *conv_b, *lru_wa, *lru_ba, *lru_wx, *lru_bx, *lru_lambda,
        *w_lru_out, *w_attn_out, *attn_sinks, *rel_bias, *w_out, *norm2_g, *w_ff1, *w_ff2, *final_g;
    float* out; unsigned char* ws;
};

__device__ __forceinline__ unsigned cvt_pk_bf16(float lo, float hi) { unsigned r; asm volatile("v_cvt_pk_bf16_f32 %0, %1, %2" : "=v"(r) : "v"(lo), "v"(hi)); return r; }
__device__ __forceinline__ float bf_lo(unsigned w) { return __uint_as_float(w << 16); }
__device__ __forceinline__ float bf_hi(unsigned w) { return __uint_as_float(w & 0xffff0000u); }
__device__ __forceinline__ float fast_sigmoid(float x) { return __builtin_amdgcn_rcpf(1.0f + __builtin_amdgcn_exp2f(-LOG2E * x)); }
__device__ __forceinline__ float gelu_tanh(float x) { const float u = x + 0.044715f * x * x * x; return x * __builtin_amdgcn_rcpf(1.0f + __builtin_amdgcn_exp2f(-2.3022082f * u)); }
__device__ __forceinline__ float wave_sum(float v) {
#pragma unroll
    for (int o = 1; o < 64; o <<= 1) v += __shfl_xor(v, o);
    return v;
}

namespace pg8 {
constexpr int BM = 256, BK = 64, HALF = 128, HTB = HALF * BK * 2, STAGE_BYTES = 8 * HTB, NXCD = 8, WGM = 8;
__host__ __device__ __forceinline__ int lds_byte(int r, int c) { const int st = (r >> 4) * 2 + (c >> 5), rr = r & 15, cc = c & 31, ob = rr * 64 + cc * 2; return st * 1024 + (ob ^ (((ob >> 9) & 1) << 5)); }
__host__ __device__ __forceinline__ void stage_rc(int b, int& R, int& C) { const int st = b / 1024, sb = b % 1024, swz = sb ^ (((sb >> 9) & 1) << 5); R = (st >> 1) * 16 + swz / 64; C = (st & 1) * 32 + (swz % 64) / 2; }
__host__ __device__ __forceinline__ int perm32(int rho) { const int n = rho >> 4, i = rho & 15; return 8 * (i >> 2) + 4 * n + (i & 3); }

struct Unit { int pm, pn; };
struct Gemm { const bf16_t* A; const bf16_t* Bt; int M, N, K, lda, ldb; };

struct StaticOrder {
    int nM, nN, nwg, G, c;
    __device__ void init(int M, int N, int G_, int c_) { nM = M / BM; nN = N / BM; nwg = nM * nN; G = G_; c = c_; }
    __device__ bool next(int i, Unit& u) const {
        const long L = (long)i * G + c; if (L >= nwg) return false;
        int wgid = (int)L; { const int q = nwg / NXCD, r = nwg % NXCD, xcd = wgid % NXCD, off = wgid / NXCD; wgid = (xcd < r ? xcd * (q + 1) : r * (q + 1) + (xcd - r) * q) + off; }
        const int nig = WGM * nN, gid = wgid / nig, fm = gid * WGM, gsz = (nM - fm) < WGM ? (nM - fm) : WGM;
        u.pm = fm + ((wgid % nig) % gsz); u.pn = (wgid % nig) / gsz; return true;
    }
};

template <class Epi>
__device__ __forceinline__ void gemm_phase(LAS unsigned char* lds, const Gemm g, const StaticOrder& S, const Epi& E) {
    int tid_ = threadIdx.x; asm volatile("" : "+v"(tid_));
    const int tid = tid_, wid = __builtin_amdgcn_readfirstlane(tid >> 6), lane = tid & 63, wr = wid >> 2, wc = wid & 3, fr = lane & 15, fq = lane >> 4;
    const int K = g.K, nt = K / BK;
    unsigned voffA[2], voffB[2];
#pragma unroll
    for (int i = 0; i < 2; ++i) { int R, C; stage_rc(tid * 16 + i * 8192, R, C); const int Rb = (R & ~31) + perm32(R & 31);
        voffA[i] = (unsigned)(R * g.lda + C) * 2u; voffB[i] = (unsigned)(Rb * g.ldb + C) * 2u; }
    const size_t kstep = (size_t)(BK * 2);
    const size_t hstepA = (size_t)HALF * g.lda * 2, hstepB = (size_t)HALF * g.ldb * 2;
    const size_t tstepA = 2 * hstepA, tstepB = 2 * hstepB;
    const unsigned ldsw = (unsigned)wid * 1024u;
    const int aoff = lds_byte(wr * 64 + fr, fq * 8), boff = lds_byte(wc * 32 + fr, fq * 8);
#define PG8_SA(b, h) (((b) * 2 + (h)) * HTB)
#define PG8_SB(b, h) ((4 + (b) * 2 + (h)) * HTB)
#define PG8_STAGE(bufoff, gbase, voff) do { _Pragma("unroll") for (int _i = 0; _i < 2; ++_i) \
        __builtin_amdgcn_global_load_lds((const unsigned*)((const char*)(gbase) + (voff)[_i]), (LAS unsigned*)(lds + (bufoff) + ldsw + _i * 8192), 16, 0, 0); } while (0)
#define PG8_LDA(dst, b, h) do { _Pragma("unroll") for (int m = 0; m < 4; ++m) _Pragma("unroll") for (int k = 0; k < 2; ++k) dst[m][k] = *(const LAS bf16x8*)(lds + PG8_SA(b, h) + aoff + m * 2048 + k * 1024); } while (0)
#define PG8_LDB(dst, b, h) do { _Pragma("unroll") for (int n = 0; n < 2; ++n) _Pragma("unroll") for (int k = 0; k < 2; ++k) dst[n][k] = *(const LAS bf16x8*)(lds + PG8_SB(b, h) + boff + n * 2048 + k * 1024); } while (0)
#define PG8_MMA(ai, bj, At, Bt) do { __builtin_amdgcn_s_setprio(1); _Pragma("unroll") for (int m = 0; m < 4; ++m) _Pragma("unroll") for (int n = 0; n < 2; ++n) _Pragma("unroll") for (int k = 0; k < 2; ++k) \
        acc[ai][bj][m][n] = __builtin_amdgcn_mfma_f32_16x16x32_bf16(Bt[n][k], At[m][k], acc[ai][bj][m][n], 0, 0, 0); __builtin_amdgcn_s_setprio(0); } while (0)
#define PG8_WAIT_V(n) asm volatile("s_waitcnt vmcnt(" #n ")" ::: "memory")
#define PG8_WAIT_L(n) asm volatile("s_waitcnt lgkmcnt(" #n ")" ::: "memory")
#define PG8_BAR __builtin_amdgcn_s_barrier()
#define PG8_SCHED __builtin_amdgcn_sched_barrier(0)
    Unit cur, nxt; int ui = 0;
    if (!S.next(0, cur)) return;
    f32x4 acc[2][2][4][2];
#pragma unroll
    for (int a = 0; a < 2; ++a)
#pragma unroll
        for (int b = 0; b < 2; ++b)
#pragma unroll
            for (int m = 0; m < 4; ++m)
#pragma unroll
                for (int n = 0; n < 2; ++n) acc[a][b][m][n] = (f32x4){0.f, 0.f, 0.f, 0.f};
    bf16x8 At[4][2], B0[2][2], B1[2][2];
    const char* cA = (const char*)g.A + (size_t)cur.pm * tstepA; const char* cB = (const char*)g.Bt + (size_t)cur.pn * tstepB;
    PG8_STAGE(PG8_SB(0, 0), cB, voffB); PG8_STAGE(PG8_SB(0, 1), cB + hstepB, voffB); PG8_STAGE(PG8_SA(0, 0), cA, voffA); PG8_STAGE(PG8_SA(0, 1), cA + hstepA, voffA);
    if (wr == 1) PG8_BAR;
    PG8_WAIT_V(2); PG8_BAR;
    PG8_STAGE(PG8_SB(1, 0), cB + kstep, voffB); PG8_STAGE(PG8_SA(1, 0), cA + kstep, voffA); PG8_STAGE(PG8_SB(1, 1), cB + hstepB + kstep, voffB);
    PG8_WAIT_V(6); PG8_BAR;
    for (;;) {
        const bool has_next = S.next(ui + 1, nxt);
        const char* nA = has_next ? (const char*)g.A + (size_t)nxt.pm * tstepA : cA; const char* nB = has_next ? (const char*)g.Bt + (size_t)nxt.pn * tstepB : cB;
        for (int t = 0; t < nt; t += 2) {
            if constexpr (Epi::HAS_MID) { if (t == E.mid_t) E.mid(acc, cur, wr, wc, fr, fq); }
            const bool last = (t == nt - 2);
            const char* a1 = cA + (size_t)(t + 1) * kstep;
            const char* a2 = last ? nA : cA + (size_t)(t + 2) * kstep; const char* b2 = last ? nB : cB + (size_t)(t + 2) * kstep;
            const char* a3 = a2 + kstep; const char* b3 = b2 + kstep;
            PG8_LDB(B0, 0, 0); PG8_LDB(B1, 0, 1); PG8_SCHED; PG8_LDA(At, 0, 0); PG8_STAGE(PG8_SA(1, 1), a1 + hstepA, voffA);
            PG8_WAIT_V(8); PG8_WAIT_L(0); PG8_BAR; PG8_MMA(0, 0, At, B0); PG8_MMA(0, 1, At, B1); PG8_BAR; PG8_SCHED;
            PG8_LDA(At, 0, 1); PG8_STAGE(PG8_SB(0, 0), b2, voffB); PG8_STAGE(PG8_SB(0, 1), b2 + hstepB, voffB); PG8_STAGE(PG8_SA(0, 0), a2, voffA);
            PG8_WAIT_V(8); PG8_WAIT_L(0); PG8_BAR; PG8_MMA(1, 0, At, B0); PG8_MMA(1, 1, At, B1); PG8_BAR; PG8_SCHED;
            PG8_LDB(B0, 1, 0); PG8_LDB(B1, 1, 1); PG8_SCHED; PG8_LDA(At, 1, 0); PG8_STAGE(PG8_SA(0, 1), a2 + hstepA, voffA);
            PG8_WAIT_V(8); PG8_WAIT_L(0); PG8_BAR; PG8_MMA(0, 0, At, B0); PG8_MMA(0, 1, At, B1); PG8_BAR; PG8_SCHED;
            PG8_LDA(At, 1, 1); PG8_STAGE(PG8_SB(1, 0), b3, voffB); PG8_STAGE(PG8_SB(1, 1), b3 + hstepB, voffB); PG8_STAGE(PG8_SA(1, 0), a3, voffA);
            PG8_WAIT_V(8); PG8_WAIT_L(0); PG8_BAR; PG8_MMA(1, 0, At, B0); PG8_MMA(1, 1, At, B1); PG8_BAR; PG8_SCHED;
        }
        if (wr == 0) PG8_BAR;
        E(acc, cur, wr, wc, fr, fq);
        if (!has_next) break;
#pragma unroll
        for (int a = 0; a < 2; ++a)
#pragma unroll
            for (int b = 0; b < 2; ++b)
#pragma unroll
                for (int m = 0; m < 4; ++m)
#pragma unroll
                    for (int n = 0; n < 2; ++n) acc[a][b][m][n] = (f32x4){0.f, 0.f, 0.f, 0.f};
        cur = nxt; cA = nA; cB = nB; ++ui;
        if (wr == 1) PG8_BAR;
    }
    PG8_WAIT_V(0);
    PG8_BAR;
#undef PG8_SA
#undef PG8_SB
#undef PG8_STAGE
#undef PG8_LDA
#undef PG8_LDB
#undef PG8_MMA
#undef PG8_WAIT_V
#undef PG8_WAIT_L
#undef PG8_BAR
#undef PG8_SCHED
}

typedef f32x4 Acc[2][2][4][2];

struct EpiProj {
    static constexpr bool HAS_MID = false; int mid_t;
    bf16_t* O; int ldc;
    template <int ACT> __device__ __forceinline__ void body(const Acc& acc, const Unit& u, int wr, int wc, int fr, int fq) const {
        const int row0 = u.pm * BM + wr * 64 + fr, col0 = u.pn * BM + wc * 32 + 8 * fq;
#pragma unroll
        for (int ai = 0; ai < 2; ++ai)
#pragma unroll
            for (int m = 0; m < 4; ++m) { bf16_t* rowp = O + (size_t)(row0 + ai * HALF + m * 16) * ldc + col0;
#pragma unroll
                for (int bj = 0; bj < 2; ++bj) { f32x4 v0 = acc[ai][bj][m][0], v1 = acc[ai][bj][m][1];
                    if (ACT == 1) {
#pragma unroll
                        for (int e = 0; e < 4; ++e) { v0[e] = gelu_tanh(v0[e]); v1[e] = gelu_tanh(v1[e]); } }
                    if (ACT == 2) { v0 = v0 * 0.125f; v1 = v1 * 0.125f; }
                    if (ACT == 3) {
#pragma unroll
                        for (int e = 0; e < 4; ++e) { v0[e] = fast_sigmoid(v0[e]); v1[e] = fast_sigmoid(v1[e]); } }
                    if (ACT == 4) {
#pragma unroll
                        for (int e = 0; e < 4; ++e) { const float a = fmaxf(v0[e], 0.f), b = fmaxf(v1[e], 0.f); v0[e] = a * a; v1[e] = b * b; } }
                    u32x4 w; w.x = cvt_pk_bf16(v0[0], v0[1]); w.y = cvt_pk_bf16(v0[2], v0[3]); w.z = cvt_pk_bf16(v1[0], v1[1]); w.w = cvt_pk_bf16(v1[2], v1[3]);
                    *(u32x4*)(rowp + bj * HALF) = w; } }
    }
    __device__ __forceinline__ void operator()(const Acc& acc, const Unit& u, int wr, int wc, int fr, int fq) const {
        const int pn = u.pn;
        if (pn < 8) body<0>(acc, u, wr, wc, fr, fq);
        else if (pn < 16) body<1>(acc, u, wr, wc, fr, fq);
        else if (pn < 24) body<2>(acc, u, wr, wc, fr, fq);
        else if (pn < 26) body<0>(acc, u, wr, wc, fr, fq);
        else body<3>(acc, u, wr, wc, fr, fq);
    }
};
struct EpiFF1 {
    static constexpr bool HAS_MID = false; int mid_t;
    bf16_t* O; int ldc;
    __device__ __forceinline__ void operator()(const Acc& acc, const Unit& u, int wr, int wc, int fr, int fq) const {
        EpiProj e{0, O, ldc}; e.body<4>(acc, u, wr, wc, fr, fq);
    }
};
struct EpiRes {
    static constexpr bool HAS_MID = false; int mid_t;
    const float* base; float* out; const float* gate;
    __device__ __forceinline__ void operator()(const Acc& acc, const Unit& u, int wr, int wc, int fr, int fq) const {
        const int row0 = u.pm * BM + wr * 64 + fr, col0 = u.pn * BM + wc * 32 + 8 * fq;
        const float* gp = gate + (size_t)(u.pm >> 4) * NMOD + col0;
        f32x4 gv[2][2];
#pragma unroll
        for (int bj = 0; bj < 2; ++bj)
#pragma unroll
            for (int n = 0; n < 2; ++n) gv[bj][n] = *(const f32x4*)(gp + bj * HALF + 4 * n);
#pragma unroll
        for (int ai = 0; ai < 2; ++ai)
#pragma unroll
            for (int m = 0; m < 4; ++m) { const size_t off = (size_t)(row0 + ai * HALF + m * 16) * DM + col0;
#pragma unroll
                for (int bj = 0; bj < 2; ++bj)
#pragma unroll
                    for (int n = 0; n < 2; ++n) { const f32x4 bs = *(const f32x4*)(base + off + bj * HALF + 4 * n);
                        *(f32x4*)(out + off + bj * HALF + 4 * n) = bs + gv[bj][n] * acc[ai][bj][m][n]; }
                asm volatile("" ::: "memory"); }
    }
};
struct EpiMerge {
    static constexpr bool HAS_MID = true; int mid_t;
    const bf16_t* P; bf16_t* O;
    __device__ __forceinline__ void mid(Acc& acc, const Unit& u, int wr, int wc, int fr, int fq) const {
        int row0 = u.pm * BM + wr * 64 + fr, col0 = u.pn * BM + wc * 32 + 8 * fq;
        asm volatile("" : "+v"(row0), "+v"(col0));
#pragma unroll
        for (int ai = 0; ai < 2; ++ai)
#pragma unroll
            for (int m = 0; m < 4; ++m) { const bf16_t* rp = P + (size_t)(row0 + ai * HALF + m * 16) * INW + col0;
#pragma unroll
                for (int bj = 0; bj < 2; ++bj) { const u32x4 a = *(const u32x4*)(rp + C_GA + bj * HALF), b = *(const u32x4*)(rp + C_GB + bj * HALF);
#pragma unroll
                    for (int e = 0; e < 4; ++e) { const float r0 = bf_lo(a[e]) * __builtin_amdgcn_rcpf(fmaxf(bf_lo(b[e]), 1e-30f)), r1 = bf_hi(a[e]) * __builtin_amdgcn_rcpf(fmaxf(bf_hi(b[e]), 1e-30f));
                        acc[ai][bj][m][e >> 1][(e & 1) * 2] *= r0; acc[ai][bj][m][e >> 1][(e & 1) * 2 + 1] *= r1; } }
                asm volatile("" ::: "memory"); }
    }
    __device__ __forceinline__ void operator()(const Acc& acc, const Unit& u, int wr, int wc, int fr, int fq) const {
        const int row0 = u.pm * BM + wr * 64 + fr, col0 = u.pn * BM + wc * 32 + 8 * fq;
#pragma unroll
        for (int ai = 0; ai < 2; ++ai)
#pragma unroll
            for (int m = 0; m < 4; ++m) { const size_t row = (size_t)(row0 + ai * HALF + m * 16);
#pragma unroll
                for (int bj = 0; bj < 2; ++bj) { const u32x4 b = *(const u32x4*)(P + row * INW + C_GB + col0 + bj * HALF);
                    const f32x4 v0 = acc[ai][bj][m][0], v1 = acc[ai][bj][m][1];
                    u32x4 w; w.x = cvt_pk_bf16(v0[0] * bf_lo(b[0]), v0[1] * bf_hi(b[0])); w.y = cvt_pk_bf16(v0[2] * bf_lo(b[1]), v0[3] * bf_hi(b[1]));
                    w.z = cvt_pk_bf16(v1[0] * bf_lo(b[2]), v1[1] * bf_hi(b[2])); w.w = cvt_pk_bf16(v1[2] * bf_lo(b[3]), v1[3] * bf_hi(b[3]));
                    *(u32x4*)(O + row * DM + col0 + bj * HALF) = w; }
                asm volatile("" ::: "memory"); }
    }
};
}

__device__ __forceinline__ void phase_mod(const Params& p, unsigned char* lds, int tid, int lane, int wid, int G, int bid) {
    float* cs = (float*)lds;
    float* red = (float*)(lds + 65536);
    float* mod = (float*)(p.ws + WS_MOD);
    for (int item = bid; item < NMOD / 64; item += G) {
        for (int e = tid; e < NB * DM; e += 512) { const int b = e >> 11, k = e & 2047; const float v = p.c[e]; cs[k * 8 + b] = v * fast_sigmoid(v); }
        __syncthreads();
        const int col = item * 64 + lane;
        float acc[8];
#pragma unroll
        for (int b = 0; b < 8; ++b) acc[b] = 0.f;
        const float* W = p.w_ada + (size_t)(wid * 256) * NMOD + col;
#pragma unroll 8
        for (int k = 0; k < 256; ++k) {
            const float w = W[(size_t)k * NMOD];
            const f32x4 c0 = *(const f32x4*)(cs + (wid * 256 + k) * 8), c1 = *(const f32x4*)(cs + (wid * 256 + k) * 8 + 4);
            acc[0] += c0[0] * w; acc[1] += c0[1] * w; acc[2] += c0[2] * w; acc[3] += c0[3] * w;
            acc[4] += c1[0] * w; acc[5] += c1[1] * w; acc[6] += c1[2] * w; acc[7] += c1[3] * w;
        }
#pragma unroll
        for (int b = 0; b < 8; ++b) red[(wid * 8 + b) * 64 + lane] = acc[b];
        __syncthreads();
        { const int b = tid >> 6; float s = 0.f;
#pragma unroll
          for (int w = 0; w < 8; ++w) s += red[(w * 8 + b) * 64 + lane];
          mod[b * NMOD + col] = s + p.b_ada[col]; }
        __syncthreads();
    }
}
__device__ __forceinline__ void transpose_item(const float* W, int ldw, bf16_t* WT, int ldo, int koff, int nblk, int item, float* scr, int lane) {
    const int kb = item / nblk, nb = item - kb * nblk, k0 = 64 * kb, n0 = 32 * nb;
    { const int kr = lane >> 3, nc = lane & 7; f32x4 v[8];
#pragma unroll
      for (int i = 0; i < 8; ++i) v[i] = *(const f32x4*)(W + (size_t)(k0 + 8 * i + kr) * ldw + n0 + 4 * nc);
#pragma unroll
      for (int i = 0; i < 8; ++i) { float* d = scr + (8 * i + kr) * 33 + 4 * nc; d[0] = v[i][0]; d[1] = v[i][1]; d[2] = v[i][2]; d[3] = v[i][3]; } }
    asm volatile("s_waitcnt lgkmcnt(0)" ::: "memory");
    const int c = lane & 7;
#pragma unroll
    for (int j = 0; j < 4; ++j) { const int n = (lane >> 3) + 8 * j; const float* s = scr + (8 * c) * 33 + n;
        u32x4 o; o.x = cvt_pk_bf16(s[0 * 33], s[1 * 33]); o.y = cvt_pk_bf16(s[2 * 33], s[3 * 33]); o.z = cvt_pk_bf16(s[4 * 33], s[5 * 33]); o.w = cvt_pk_bf16(s[6 * 33], s[7 * 33]);
        *(u32x4*)(WT + (size_t)(n0 + n) * ldo + koff + k0 + 8 * c) = o; }
    asm volatile("s_waitcnt lgkmcnt(0)" ::: "memory");
}
__device__ __forceinline__ void phase_weights(const Params& p, unsigned char* lds, int lane, int wid, int G, int bid) {
    float* scr = (float*)(lds + wid * 16384);
    const int gw = bid * 8 + wid, NGW = G * 8;
    constexpr int I_IN = 32 * (INW / 32), I_SQ = 32 * 64, I_F1 = 32 * (DFF / 32), I_F2 = (DFF / 64) * 64, I_L = 32 * 4;
    constexpr int NITEMS = I_IN + 3 * I_SQ + I_F1 + I_F2 + 2 * I_L;
    for (int it = gw; it < NITEMS; it += NGW) {
        int r = it;
        if (r < I_IN) { transpose_item(p.w_in, INW, (bf16_t*)(p.ws + WS_WIN), DM, 0, INW / 32, r, scr, lane); continue; } r -= I_IN;
        if (r < I_SQ) { transpose_item(p.w_lru_out, DM, (bf16_t*)(p.ws + WS_WM), 4096, 0, 64, r, scr, lane); continue; } r -= I_SQ;
        if (r < I_SQ) { transpose_item(p.w_attn_out, DM, (bf16_t*)(p.ws + WS_WM), 4096, 2048, 64, r, scr, lane); continue; } r -= I_SQ;
        if (r < I_SQ) { transpose_item(p.w_out, DM, (bf16_t*)(p.ws + WS_WO), DM, 0, 64, r, scr, lane); continue; } r -= I_SQ;
        if (r < I_F1) { transpose_item(p.w_ff1, DFF, (bf16_t*)(p.ws + WS_W1), DM, 0, DFF / 32, r, scr, lane); continue; } r -= I_F1;
        if (r < I_F2) { transpose_item(p.w_ff2, DM, (bf16_t*)(p.ws + WS_W2), DFF, 0, 64, r, scr, lane); continue; } r -= I_F2;
        if (r < I_L) { transpose_item(p.lru_wa, 128, (bf16_t*)(p.ws + WS_WA), DM, 0, 4, r, scr, lane); continue; } r -= I_L;
        transpose_item(p.lru_wx, 128, (bf16_t*)(p.ws + WS_WX), DM, 0, 4, r, scr, lane);
    }
}
__device__ __forceinline__ void phase_norm_mod(const float* X, const float* g, const float* mod, int shift_off, int scale_off, bf16_t* H, int lane, int wid, int G, int bid) {
    const int gw = bid * 8 + wid, NGW = G * 8;
    for (int grp = gw; grp < MTOK / 16; grp += NGW) {
        const int row0 = grp * 16, b = row0 / SEQ;
        f32x4 cA[8], cB[8];
#pragma unroll
        for (int j = 0; j < 8; ++j) { const int col = 4 * lane + 256 * j; const f32x4 gg = *(const f32x4*)(g + col), sc = *(const f32x4*)(mod + (size_t)b * NMOD + scale_off + col);
            cA[j] = gg * (sc + 1.0f); cB[j] = *(const f32x4*)(mod + (size_t)b * NMOD + shift_off + col); }
        for (int r = 0; r < 16; ++r) {
            const float* xr = X + (size_t)(row0 + r) * DM + 4 * lane; f32x4 v[8]; float ss = 0.f;
#pragma unroll
            for (int j = 0; j < 8; ++j) { v[j] = *(const f32x4*)(xr + 256 * j); ss += (v[j][0] * v[j][0] + v[j][1] * v[j][1]) + (v[j][2] * v[j][2] + v[j][3] * v[j][3]); }
            const float rstd = rsqrtf(wave_sum(ss) * (1.0f / DM) + EPS);
            bf16_t* orow = H + (size_t)(row0 + r) * DM + 4 * lane;
#pragma unroll
            for (int j = 0; j < 8; ++j) { const f32x4 o = v[j] * rstd * cA[j] + cB[j]; u32x2 w; w.x = cvt_pk_bf16(o[0], o[1]); w.y = cvt_pk_bf16(o[2], o[3]); *(u32x2*)(orow + 256 * j) = w; }
        }
    }
}
__device__ __forceinline__ void phase_final_norm(float* X, const float* g, int lane, int wid, int G, int bid) {
    const int gw = bid * 8 + wid, NGW = G * 8;
    f32x4 cA[8];
#pragma unroll
    for (int j = 0; j < 8; ++j) cA[j] = *(const f32x4*)(g + 4 * lane + 256 * j);
    for (int row = gw; row < MTOK; row += NGW) {
        float* xr = X + (size_t)row * DM + 4 * lane; f32x4 v[8]; float ss = 0.f;
#pragma unroll
        for (int j = 0; j < 8; ++j) { v[j] = *(const f32x4*)(xr + 256 * j); ss += (v[j][0] * v[j][0] + v[j][1] * v[j][1]) + (v[j][2] * v[j][2] + v[j][3] * v[j][3]); }
        const float rstd = rsqrtf(wave_sum(ss) * (1.0f / DM) + EPS);
#pragma unroll
        for (int j = 0; j < 8; ++j) *(f32x4*)(xr + 256 * j) = v[j] * rstd * cA[j];
    }
}

__device__ __forceinline__ void phase_lru(const Params& p, unsigned char* lds, int tid, int lane, int wid, int G, int bid) {
    bf16_t* PROJ = (bf16_t*)(p.ws + WS_PROJ);
    const bf16_t* WaT = (const bf16_t*)(p.ws + WS_WA); const bf16_t* WxT = (const bf16_t*)(p.ws + WS_WX);
    unsigned char* XC = lds;
    float* AS = (float*)(lds + 69632);
    float* US = (float*)(lds + 102400);
    float* SEG = (float*)(lds + 135168);
    float* CAR = (float*)(lds + 139264);
    unsigned char* WB = lds + 139520;
    const int r32 = lane & 31, hi = lane >> 5;
    for (int item = bid; item < 512; item += G) {
        const int b = item >> 6, hblk = (item >> 2) & 15, jq = item & 3;
        const int cg4 = tid & 31, ts = tid >> 5;
        const int chbase = hblk * 128 + cg4 * 4;
#pragma unroll
        for (int q = 0; q < 2; ++q) { const int idx = tid + 512 * q, mat = idx >> 9, j = (idx >> 4) & 31, ch = idx & 15;
            const u32x4 w = *(const u32x4*)((mat ? WxT : WaT) + (size_t)(32 * jq + j) * DM + hblk * 128 + 8 * ch);
            *(u32x4*)(WB + (mat * 32 + j) * 272 + ch * 16) = w; }
        const int jj = hblk * 128 + 32 * jq + r32;
        const float nba = -LOG2E * p.lru_ba[jj], nbx = -LOG2E * p.lru_bx[jj]; const float nsp = -LOG2E * 8.0f * log1pf(expf(-p.lru_lambda[jj]));
        if (tid < 32) CAR[tid] = 0.f;
        u32x2 xr[19];
#pragma unroll
        for (int i = 0; i < 19; ++i) { const int tr = 16 * ts - 3 + i; xr[i] = (u32x2){0u, 0u};
            if (tr >= 0) xr[i] = *(const u32x2*)(PROJ + (size_t)((long)b * SEQ + tr) * INW + C_LX + chbase); }
        for (int c = 0; c < 16; ++c) {
            const int t0 = c * 256; const size_t tokbase = (size_t)b * SEQ + t0;
            f32x4 cw[4], cb;
            { const float* cwp = p.conv_w + chbase; const float* cbp = p.conv_b + chbase; asm volatile("" : "+v"(cwp), "+v"(cbp));
#pragma unroll
              for (int k = 0; k < 4; ++k) cw[k] = *(const f32x4*)(cwp + k * DM);
              cb = *(const f32x4*)(cbp); }
            { f32x4 o[16];
#pragma unroll
              for (int i = 0; i < 19; ++i) { const f32x4 xf = (f32x4){bf_lo(xr[i][0]), bf_hi(xr[i][0]), bf_lo(xr[i][1]), bf_hi(xr[i][1])};
#pragma unroll
                  for (int k = 0; k < 4; ++k) { const int tl = i - k;
                      if (tl >= 0 && tl < 16) o[tl] = (k == 0 ? cb : o[tl]) + cw[k] * xf; }
                  if (i >= 3) { const int tl = i - 3;
                      u32x2 w; w.x = cvt_pk_bf16(o[tl][0], o[tl][1]); w.y = cvt_pk_bf16(o[tl][2], o[tl][3]);
                      *(u32x2*)(XC + (16 * ts + tl) * 272 + cg4 * 8) = w; }
                  __builtin_amdgcn_sched_barrier(0); } }
            __syncthreads();
            f32x16 pa = {}, px = {};
#pragma unroll
            for (int s = 0; s < 8; ++s) { const bf16x8 af = *(const bf16x8*)(XC + (32 * wid + r32) * 272 + (16 * s + 8 * hi) * 2);
                const bf16x8 fa = *(const bf16x8*)(WB + r32 * 272 + (16 * s + 8 * hi) * 2), fx = *(const bf16x8*)(WB + (32 + r32) * 272 + (16 * s + 8 * hi) * 2);
                pa = __builtin_amdgcn_mfma_f32_32x32x16_bf16(af, fa, pa, 0, 0, 0); px = __builtin_amdgcn_mfma_f32_32x32x16_bf16(af, fx, px, 0, 0, 0); }
#pragma unroll
            for (int reg = 0; reg < 16; ++reg) { const int t = 32 * wid + (reg & 3) + 8 * (reg >> 2) + 4 * hi;
                const float xcv = __uint_as_float(((unsigned)*(const bf16_t*)(XC + t * 272 + (32 * jq + r32) * 2)) << 16);
                const float rg = __builtin_amdgcn_rcpf(1.0f + __builtin_amdgcn_exp2f(pa[reg] * -LOG2E + nba)), ig = __builtin_amdgcn_rcpf(1.0f + __builtin_amdgcn_exp2f(px[reg] * -LOG2E + nbx));
                const float a = __builtin_amdgcn_exp2f(rg * nsp);
                const float mult = __builtin_amdgcn_sqrtf(fmaxf(1.0f - a * a, 0.f));
                AS[t * 32 + r32] = a; US[t * 32 + r32] = mult * ig * xcv;
                if ((reg & 3) == 3) __builtin_amdgcn_sched_barrier(0); }
            if (c == 0 && wid == 0 && hi == 0) {
                const float xcv = __uint_as_float(((unsigned)*(const bf16_t*)(XC + (32 * jq + r32) * 2)) << 16);
                US[r32] = __builtin_amdgcn_rcpf(1.0f + __builtin_amdgcn_exp2f(px[0] * -LOG2E + nbx)) * xcv; }
            __syncthreads();
            if (c < 15) {
#pragma unroll
                for (int i = 0; i < 19; ++i) xr[i] = *(const u32x2*)(PROJ + (size_t)((long)tokbase + 256 + 16 * ts - 3 + i) * INW + C_LX + chbase); }
            u32x4 gq2[2];
#pragma unroll
            for (int q = 0; q < 2; ++q) { const int idx = tid + 512 * q, t = idx >> 2, c8 = idx & 3; gq2[q] = *(const u32x4*)(PROJ + (tokbase + t) * INW + C_LG + hblk * 128 + 32 * jq + 8 * c8); }
            { const int j = tid & 31, seg = tid >> 5; float A = 1.f, h = 0.f; float av[16], uv[16];
#pragma unroll
              for (int tt = 0; tt < 16; ++tt) { const int idx = (16 * seg + tt) * 32 + j; av[tt] = AS[idx]; uv[tt] = US[idx]; }
#pragma unroll
              for (int tt = 0; tt < 16; ++tt) { h = av[tt] * h + uv[tt]; A *= av[tt]; }
              SEG[seg * 32 + j] = A; SEG[512 + seg * 32 + j] = h;
              __syncthreads();
              float hin = CAR[(c & 1) * 32 + j];
              for (int s2 = 0; s2 < seg; ++s2) hin = SEG[s2 * 32 + j] * hin + SEG[512 + s2 * 32 + j];
              h = hin;
#pragma unroll
              for (int tt = 0; tt < 16; ++tt) { h = av[tt] * h + uv[tt]; US[(16 * seg + tt) * 32 + j] = h; }
              if (seg == 15) CAR[((c + 1) & 1) * 32 + j] = h; }
            __syncthreads();
#pragma unroll
            for (int q = 0; q < 2; ++q) { const int idx = tid + 512 * q, t = idx >> 2, c8 = idx & 3;
                const f32x4 h0 = *(const f32x4*)(US + t * 32 + 8 * c8), h1 = *(const f32x4*)(US + t * 32 + 8 * c8 + 4);
                bf16_t* gp = PROJ + (tokbase + t) * INW + C_LG + hblk * 128 + 32 * jq + 8 * c8; const u32x4 gq = gq2[q];
                u32x4 w; w.x = cvt_pk_bf16(h0[0] * bf_lo(gq[0]), h0[1] * bf_hi(gq[0])); w.y = cvt_pk_bf16(h0[2] * bf_lo(gq[1]), h0[3] * bf_hi(gq[1]));
                w.z = cvt_pk_bf16(h1[0] * bf_lo(gq[2]), h1[1] * bf_hi(gq[2])); w.w = cvt_pk_bf16(h1[2] * bf_lo(gq[3]), h1[3] * bf_hi(gq[3]));
                *(u32x4*)gp = w; }
        }
        __syncthreads();
    }
}

__device__ __forceinline__ void phase_attn(const Params& p, unsigned char* lds, int tid, int lane, int wid, int G, int bid) {
    bf16_t* PROJ = (bf16_t*)(p.ws + WS_PROJ);
    unsigned char* KS = lds;
    unsigned char* VT = lds + 36864;
    float* BT = (float*)(lds + 70144);
    const int r32 = lane & 31, hi = lane >> 5;
    for (int u = bid; u < 1024; u += G) {
        const int hk = u & 3, n = (u >> 2) & 31, b = u >> 7;
#pragma unroll
        for (int q = 0; q < 4; ++q) { const int idx = tid + 512 * q, row = idx >> 3, ch = idx & 7; const int tok = 128 * (n - 1) + row;
            u32x4 kv = (u32x4){0u, 0u, 0u, 0u}, vv = kv;
            if (tok >= 0) { const bf16_t* base = PROJ + ((size_t)b * SEQ + tok) * INW; kv = *(const u32x4*)(base + C_K + hk * 64 + 8 * ch); vv = *(const u32x4*)(base + C_V + hk * 64 + 8 * ch); }
            *(u32x4*)(KS + row * 144 + ch * 16) = kv;
#pragma unroll
            for (int e = 0; e < 4; ++e) { *(bf16_t*)(VT + (8 * ch + 2 * e) * 520 + row * 2) = (bf16_t)(vv[e] & 0xffffu); *(bf16_t*)(VT + (8 * ch + 2 * e + 1) * 520 + row * 2) = (bf16_t)(vv[e] >> 16); } }
        for (int e = tid; e < 1536; e += 512) { const int g = e / 192, idx = e - g * 192, rel = idx - 32; float v = NEGF;
            if (rel >= 0 && rel < 128) { int bk = rel; if (rel >= 16) { bk = 16 + (int)(logf((float)rel * (1.0f / 16.0f)) / 2.0794415416798357f * 16.0f); bk = bk > 31 ? 31 : bk; }
                v = p.rel_bias[bk * 32 + hk * 8 + g]; }
            BT[e] = v; }
        __syncthreads();
        const int head = hk * 8 + wid; const float sink = p.attn_sinks[head];
        for (int i = 0; i < 4; ++i) {
            const size_t qtok = (size_t)b * SEQ + 128 * n + 32 * i + r32;
            bf16_t* qp = PROJ + qtok * INW + C_Q + head * 64;
            bf16x8 qf[4];
#pragma unroll
            for (int s = 0; s < 4; ++s) qf[s] = *(const bf16x8*)(qp + 16 * s + 8 * hi);
            f32x16 S[5];
#pragma unroll
            for (int dj = 0; dj < 5; ++dj) { f32x16 acc = {};
#pragma unroll
                for (int s = 0; s < 4; ++s) { const bf16x8 kf = *(const bf16x8*)(KS + (32 * (i + dj) + r32) * 144 + (16 * s + 8 * hi) * 2); acc = __builtin_amdgcn_mfma_f32_32x32x16_bf16(kf, qf[s], acc, 0, 0, 0); }
                S[dj] = acc; }
            float m = sink;
#pragma unroll
            for (int dj = 0; dj < 5; ++dj) { const bool dead = (n == 0) && (i + dj < 4);
#pragma unroll
                for (int reg = 0; reg < 16; ++reg) { const int kr = (reg & 3) + 8 * (reg >> 2) + 4 * hi; float v = S[dj][reg] + BT[wid * 192 + 160 - 32 * dj + r32 - kr]; v = dead ? NEGF : v; S[dj][reg] = v; m = fmaxf(m, v); } }
            m = fmaxf(m, __shfl_xor(m, 32));
            float l = 0.f; const float mb = m * LOG2E;
#pragma unroll
            for (int dj = 0; dj < 5; ++dj)
#pragma unroll
                for (int reg = 0; reg < 16; ++reg) { const float e = __builtin_amdgcn_exp2f(S[dj][reg] * LOG2E - mb); S[dj][reg] = e; l += e; }
            l += __shfl_xor(l, 32); l += __builtin_amdgcn_exp2f(sink * LOG2E - mb);
            const float inv = 1.0f / l;
            f32x16 O0 = {}, O1 = {};
#pragma unroll
            for (int dj = 0; dj < 5; ++dj)
#pragma unroll
                for (int ks = 0; ks < 2; ++ks) { u32x4 pw; pw.x = cvt_pk_bf16(S[dj][8 * ks + 0], S[dj][8 * ks + 1]); pw.y = cvt_pk_bf16(S[dj][8 * ks + 2], S[dj][8 * ks + 3]);
                    pw.z = cvt_pk_bf16(S[dj][8 * ks + 4], S[dj][8 * ks + 5]); pw.w = cvt_pk_bf16(S[dj][8 * ks + 6], S[dj][8 * ks + 7]);
                    const bf16x8 pf = __builtin_bit_cast(bf16x8, pw);
                    const unsigned char* vp = VT + r32 * 520 + (32 * (i + dj) + 16 * ks + 4 * hi) * 2;
                    { const u32x2 lo = *(const u32x2*)vp, h2 = *(const u32x2*)(vp + 16); const u32x4 vw = (u32x4){lo.x, lo.y, h2.x, h2.y};
                      O0 = __builtin_amdgcn_mfma_f32_32x32x16_bf16(__builtin_bit_cast(bf16x8, vw), pf, O0, 0, 0, 0); }
                    { const u32x2 lo = *(const u32x2*)(vp + 32 * 520), h2 = *(const u32x2*)(vp + 32 * 520 + 16); const u32x4 vw = (u32x4){lo.x, lo.y, h2.x, h2.y};
                      O1 = __builtin_amdgcn_mfma_f32_32x32x16_bf16(__builtin_bit_cast(bf16x8, vw), pf, O1, 0, 0, 0); } }
#pragma unroll
            for (int c4 = 0; c4 < 4; ++c4) { u32x2 w0, w1;
                w0.x = cvt_pk_bf16(O0[4 * c4] * inv, O0[4 * c4 + 1] * inv); w0.y = cvt_pk_bf16(O0[4 * c4 + 2] * inv, O0[4 * c4 + 3] * inv);
                w1.x = cvt_pk_bf16(O1[4 * c4] * inv, O1[4 * c4 + 1] * inv); w1.y = cvt_pk_bf16(O1[4 * c4 + 2] * inv, O1[4 * c4 + 3] * inv);
                *(u32x2*)(qp + 8 * c4 + 4 * hi) = w0; *(u32x2*)(qp + 32 + 8 * c4 + 4 * hi) = w1; }
        }
        __syncthreads();
    }
}


#define XB_TMO      128
#define XB_XCNT(j)  (256  + 64 * (j))
#define XB_XSUB(j)  (1280 + 64 * (j))
#define XB_XGEN(j)  (2304 + 64 * (j))
#define XB_TOP      3328
#define XB_TOPGEN   3392
#define XCD_BAR_WORDS 3456
#define XB_SPIN_CAP (1u << 22)
__device__ __forceinline__ unsigned xb_ld(unsigned* p)              { return __hip_atomic_load(p, __ATOMIC_RELAXED, __HIP_MEMORY_SCOPE_AGENT); }
__device__ __forceinline__ unsigned xb_add(unsigned* p, unsigned v) { return __hip_atomic_fetch_add(p, v, __ATOMIC_RELAXED, __HIP_MEMORY_SCOPE_AGENT); }
__device__ __forceinline__ unsigned xb_xcc_id() { return (unsigned)__builtin_amdgcn_s_getreg((3 << 11) | 20) & 0xFu; }
#define XB_SPIN(cond, bar) do { unsigned _sp = 0; while (cond) { __builtin_amdgcn_s_sleep(1); \
    if ((++_sp & 255u) == 0u) { if (xb_ld(&(bar)[XB_TMO])) break; if (_sp > XB_SPIN_CAP) { atomicAdd(&(bar)[XB_TMO], 1u); break; } } } } while (0)
struct XcdBarrier { unsigned* bar; unsigned x; volatile LAS unsigned* st; };
__device__ __forceinline__ XcdBarrier xcd_barrier_post(unsigned* bar, volatile LAS unsigned* st) {
    XcdBarrier b; b.bar = bar; b.x = xb_xcc_id(); b.st = st;
    if (threadIdx.x == 0) (void)xb_add(&bar[XB_XCNT(b.x)], 1u);
    return b;
}
__device__ __forceinline__ void xcd_barrier_complete(unsigned* bar, unsigned x, unsigned& nloc, unsigned& nx) {
    const unsigned G = gridDim.x * gridDim.y * gridDim.z;
    unsigned sum, cnt, mine, sp = 0u;
    for (;;) {
        sum = 0u; cnt = 0u; mine = 0u;
#pragma unroll
        for (unsigned j = 0; j < 16; ++j) { const unsigned c = xb_ld(&bar[XB_XCNT(j)]); sum += c; cnt += (c > 0u) ? 1u : 0u; mine = (j == x) ? c : mine; }
        if (sum == G) break;
        __builtin_amdgcn_s_sleep(1);
        if ((++sp & 255u) == 0u) { if (xb_ld(&bar[XB_TMO])) break; if (sp > XB_SPIN_CAP) { atomicAdd(&bar[XB_TMO], 1u); break; } }
    }
    nloc = mine > 0u ? mine : 1u; nx = cnt > 0u ? cnt : 1u;
}
__device__ __forceinline__ void xcd_barrier(const XcdBarrier& b) {
    asm volatile("s_waitcnt vmcnt(0)" ::: "memory");
    __syncthreads();
    if (threadIdx.x == 0) {
        unsigned* bar = b.bar;
        __builtin_amdgcn_s_waitcnt(0);
        unsigned nloc = b.st[0], nx = b.st[1];
        if (nloc == 0u) { xcd_barrier_complete(bar, b.x, nloc, nx); b.st[0] = nloc; b.st[1] = nx; }
        const unsigned old = xb_add(&bar[XB_XSUB(b.x)], 1u);
        const unsigned gen = old / nloc;
        if (old + 1u == (gen + 1u) * nloc) {
            __builtin_amdgcn_fence(__ATOMIC_RELEASE, "agent");
            asm volatile("s_waitcnt vmcnt(0)" ::: "memory");
            const unsigned og = xb_add(&bar[XB_TOP], 1u);
            const unsigned tg = og / nx;
            if (og + 1u == (tg + 1u) * nx) xb_add(&bar[XB_TOPGEN], 1u);
            else XB_SPIN(xb_ld(&bar[XB_TOPGEN]) == tg, bar);
            __builtin_amdgcn_fence(__ATOMIC_ACQUIRE, "agent");
            xb_add(&bar[XB_XGEN(b.x)], 1u);
            asm volatile("s_waitcnt vmcnt(0)" ::: "memory");
        } else {
            XB_SPIN(xb_ld(&bar[XB_XGEN(b.x)]) == gen, bar);
            __builtin_amdgcn_fence(__ATOMIC_ACQUIRE, "agent");
            asm volatile("s_waitcnt vmcnt(0)" ::: "memory");
        }
    }
    __syncthreads();
}

#ifndef PH_MASK
#define PH_MASK 0xFFFF
#endif
#define PH(k) if constexpr ((PH_MASK >> (k)) & 1)
__global__ void __launch_bounds__(512) fwd_megakernel(Params p) {
    extern __shared__ __attribute__((aligned(16))) unsigned char lds[];
    cg::grid_group grid = cg::this_grid();
    const int wid = __builtin_amdgcn_readfirstlane((int)threadIdx.x >> 6);
    const int G = gridDim.x, bid = blockIdx.x;
#define TIDS int tid = threadIdx.x; asm volatile("" : "+v"(tid)); const int lane = tid & 63; (void)lane;
    LAS unsigned char* lds3 = (LAS unsigned char*)lds;
    float* mod = (float*)(p.ws + WS_MOD);
    bf16_t* H = (bf16_t*)(p.ws + WS_H);
    bf16_t* PROJ = (bf16_t*)(p.ws + WS_PROJ);
    volatile LAS unsigned* bst = (volatile LAS unsigned*)(lds3 + LDS_BYTES - 64);
    if (threadIdx.x < 2) bst[threadIdx.x] = 0u;
    __syncthreads();
    const XcdBarrier xbar = xcd_barrier_post((unsigned*)(p.ws + WS_CTL), bst);
    if (p.ws == nullptr) grid.sync();
#ifdef PROBE_A
    unsigned long long ts_[12]; int nts_ = 0;
#define STAMP() do { ts_[nts_++] = __builtin_amdgcn_s_memrealtime(); } while (0)
#define GRID_SYNC() do { xcd_barrier(xbar); STAMP(); } while (0)
    STAMP();
#else
#define GRID_SYNC() xcd_barrier(xbar)
#endif

    PH(0) { TIDS phase_mod(p, lds, tid, lane, wid, G, bid); }
    PH(1) { TIDS phase_weights(p, lds, lane, wid, G, bid); }
    GRID_SYNC();
    PH(2) { TIDS phase_norm_mod(p.x, p.norm1_g, mod, 0, DM, H, lane, wid, G, bid); }
    GRID_SYNC();
    PH(3) { pg8::Gemm g{H, (const bf16_t*)(p.ws + WS_WIN), MTOK, INW, DM, DM, DM}; pg8::StaticOrder S; S.init(MTOK, INW, G, bid);
      pg8::EpiProj E{0, PROJ, INW}; pg8::gemm_phase(lds3, g, S, E); }
    GRID_SYNC();
    PH(4) { TIDS phase_lru(p, lds, tid, lane, wid, G, bid); }
    PH(5) { TIDS phase_attn(p, lds, tid, lane, wid, G, bid); }
    GRID_SYNC();
    PH(6) { pg8::Gemm g{PROJ + C_LG, (const bf16_t*)(p.ws + WS_WM), MTOK, DM, 4096, INW, 4096}; pg8::StaticOrder S; S.init(MTOK, DM, G, bid);
      pg8::EpiMerge E{32, PROJ, H}; pg8::gemm_phase(lds3, g, S, E); }
    GRID_SYNC();
    PH(7) { pg8::Gemm g{H, (const bf16_t*)(p.ws + WS_WO), MTOK, DM, DM, DM, DM}; pg8::StaticOrder S; S.init(MTOK, DM, G, bid);
      pg8::EpiRes E{0, p.x, p.out, mod + 2 * DM}; pg8::gemm_phase(lds3, g, S, E); }
    GRID_SYNC();
    PH(8) { TIDS phase_norm_mod(p.out, p.norm2_g, mod, 3 * DM, 4 * DM, H, lane, wid, G, bid); }
    GRID_SYNC();
    PH(9) { pg8::Gemm g{H, (const bf16_t*)(p.ws + WS_W1), MTOK, DFF, DM, DM, DM}; pg8::StaticOrder S; S.init(MTOK, DFF, G, bid);
      pg8::EpiFF1 E{0, PROJ, DFF}; pg8::gemm_phase(lds3, g, S, E); }
    GRID_SYNC();
    PH(10) { pg8::Gemm g{PROJ, (const bf16_t*)(p.ws + WS_W2), MTOK, DM, DFF, DFF, DFF}; pg8::StaticOrder S; S.init(MTOK, DM, G, bid);
      pg8::EpiRes E{0, p.out, p.out, mod + 5 * DM}; pg8::gemm_phase(lds3, g, S, E); }
    GRID_SYNC();
    PH(11) { TIDS phase_final_norm(p.out, p.final_g, lane, wid, G, bid); }
#ifdef PROBE_A
    GRID_SYNC();
    if (bid == 0 && threadIdx.x < 64) {
        const unsigned long long dA = ts_[PROBE_A + 1] - ts_[PROBE_A], dB = ts_[PROBE_B + 1] - ts_[PROBE_B];
        const int n = (int)(dB * 16ull / 100ull);
        for (int i = threadIdx.x; i < n; i += 64) p.out[i] += 0.125f;
        const unsigned long long t0 = __builtin_amdgcn_s_memrealtime();
        while (__builtin_amdgcn_s_memrealtime() - t0 < 8ull * dA) __builtin_amdgcn_s_sleep(8);
    }
#endif
}

extern "C" void kernel_launch(void* const* d_in, const int* in_sizes, int n_in, void* d_out, int out_size, void* d_ws, size_t ws_size, hipStream_t stream) {
    static int grid_blocks = 0;
    if (grid_blocks == 0) {
        if (n_in != 22 || ws_size < WS_END || out_size != MTOK * DM) { fprintf(stderr, "kernel_launch: unexpected shapes (n_in %d, ws %zu need %zu, out %d)\n", n_in, ws_size, (size_t)WS_END, out_size); grid_blocks = -1; return; }
        int dev = 0, cus = 0, per_cu = 0;
        hipGetDevice(&dev);
        hipDeviceGetAttribute(&cus, hipDeviceAttributeMultiprocessorCount, dev);
        hipFuncSetAttribute((const void*)fwd_megakernel, hipFuncAttributeMaxDynamicSharedMemorySize, LDS_BYTES);
        hipOccupancyMaxActiveBlocksPerMultiprocessor(&per_cu, (const void*)fwd_megakernel, 512, LDS_BYTES);
        if (per_cu < 1) { fprintf(stderr, "kernel_launch: occupancy query says %d blocks/CU\n", per_cu); per_cu = 1; }
        grid_blocks = cus * per_cu;
    }
    if (grid_blocks < 0) return;
    Params p{};
    const float** pp = (const float**)&p;
    for (int i = 0; i < 22; ++i) pp[i] = (const float*)d_in[i];
    p.out = (float*)d_out; p.ws = (unsigned char*)d_ws;
    if (hipMemsetAsync((unsigned char*)d_ws + WS_CTL, 0, CTL_BYTES, stream) != hipSuccess) { fprintf(stderr, "kernel_launch: memset of barrier words failed\n"); return; }
    void* args[] = {&p};
    hipError_t e = hipLaunchCooperativeKernel((const void*)fwd_megakernel, dim3(grid_blocks), dim3(512), args, LDS_BYTES, stream);
    if (e != hipSuccess) fprintf(stderr, "cooperative launch failed: %s (grid %d)\n", hipGetErrorString(e), grid_blocks);
}
```

```cpp
#include <hip/hip_runtime.h>
#include <hip/hip_cooperative_groups.h>
#include <cstdio>
#include <cstdint>
namespace cg = cooperative_groups;

#define LAS __attribute__((address_space(3)))
typedef unsigned short bf16_t;
typedef short bf16x8 __attribute__((ext_vector_type(8)));
typedef float f32x4 __attribute__((ext_vector_type(4)));
typedef float f32x2 __attribute__((ext_vector_type(2)));
typedef float f32x16 __attribute__((ext_vector_type(16)));
typedef unsigned u32x4 __attribute__((ext_vector_type(4)));
typedef unsigned u32x2 __attribute__((ext_vector_type(2)));

constexpr int DM = 2048, NB = 8, SEQ = 4096, MTOK = NB * SEQ;
constexpr int INW = 10752, DFF = 8192, NMOD = 6 * DM;
constexpr int C_LX = 0, C_LG = 2048, C_Q = 4096, C_K = 6144, C_V = 6400, C_GA = 6656, C_GB = 8704;
constexpr float EPS = 1e-6f, NEGF = -1e30f, LOG2E = 1.4426950408889634f;

constexpr size_t WS_MOD = 0;
constexpr size_t WS_CTL = 512u << 10, CTL_BYTES = 16384;
constexpr size_t WS_WIN = 1u << 20;
constexpr size_t WS_WM = WS_WIN + (size_t)INW * DM * 2;
constexpr size_t WS_WO = WS_WM + (size_t)DM * 4096 * 2;
constexpr size_t WS_W1 = WS_WO + (size_t)DM * DM * 2;
constexpr size_t WS_W2 = WS_W1 + (size_t)DFF * DM * 2;
constexpr size_t WS_WA = WS_W2 + (size_t)DFF * DM * 2;
constexpr size_t WS_WX = WS_WA + (size_t)128 * DM * 2;
constexpr size_t WS_H = WS_WX + (size_t)128 * DM * 2;
constexpr size_t WS_PROJ = WS_H + (size_t)MTOK * DM * 2;
constexpr size_t WS_END = WS_PROJ + (size_t)MTOK * INW * 2;

constexpr int LDS_BYTES = 163840;

struct Params {
    const float *x, *c, *w_ada, *b_ada, *norm1_g, *w_in, *conv_w, *conv_b, *lru_wa, *lru_ba, *lru_wx, *lru_bx, *lru_lambda,
        *w_lru_out, *w_attn_out, *attn_sinks, *rel_bias, *w_out, *norm2_g, *w_ff1, *w_ff2, *final_g;
    float* out; unsigned char* ws;
};

__device__ __forceinline__ unsigned cvt_pk_bf16(float lo, float hi) { unsigned r; asm volatile("v_cvt_pk_bf16_f32 %0, %1, %2" : "=v"(r) : "v"(lo), "v"(hi)); return r; }
__device__ __forceinline__ float bf_lo(unsigned w) { return __uint_as_float(w << 16); }
__device__ __forceinline__ float bf_hi(unsigned w) { return __uint_as_float(w & 0xffff0000u); }
__device__ __forceinline__ float fast_sigmoid(float x) { return __builtin_amdgcn_rcpf(1.0f + __builtin_amdgcn_exp2f(-LOG2E * x)); }
__device__ __forceinline__ float gelu_tanh(float x) { const float u = x + 0.044715f * x * x * x; return x * __builtin_amdgcn_rcpf(1.0f + __builtin_amdgcn_exp2f(-2.3022082f * u)); }
__device__ __forceinline__ float wave_sum(float v) {
#pragma unroll
    for (int o = 1; o < 64; o <<= 1) v += __shfl_xor(v, o);
    return v;
}

namespace pg8 {
constexpr int BM = 256, BK = 64, HALF = 128, HTB = HALF * BK * 2, STAGE_BYTES = 8 * HTB, NXCD = 8, WGM = 8;
__host__ __device__ __forceinline__ int lds_byte(int r, int c) { const int st = (r >> 4) * 2 + (c >> 5), rr = r & 15, cc = c & 31, ob = rr * 64 + cc * 2; return st * 1024 + (ob ^ (((ob >> 9) & 1) << 5)); }
__host__ __device__ __forceinline__ void stage_rc(int b, int& R, int& C) { const int st = b / 1024, sb = b % 1024, swz = sb ^ (((sb >> 9) & 1) << 5); R = (st >> 1) * 16 + swz / 64; C = (st & 1) * 32 + (swz % 64) / 2; }
__host__ __device__ __forceinline__ int perm32(int rho) { const int n = rho >> 4, i = rho & 15; return 8 * (i >> 2) + 4 * n + (i & 3); }

struct Unit { int pm, pn; };
struct Gemm { const bf16_t* A; const bf16_t* Bt; int M, N, K, lda, ldb; };

struct StaticOrder {
    int nM, nN, nwg, G, c;
    __device__ void init(int M, int N, int G_, int c_) { nM = M / BM; nN = N / BM; nwg = nM * nN; G = G_; c = c_; }
    __device__ bool next(int i, Unit& u) const {
        const long L = (long)i * G + c; if (L >= nwg) return false;
        int wgid = (int)L; { const int q = nwg / NXCD, r = nwg % NXCD, xcd = wgid % NXCD, off = wgid / NXCD; wgid = (xcd < r ? xcd * (q + 1) : r * (q + 1) + (xcd - r) * q) + off; }
        const int nig = WGM * nN, gid = wgid / nig, fm = gid * WGM, gsz = (nM - fm) < WGM ? (nM - fm) : WGM;
        u.pm = fm + ((wgid % nig) % gsz); u.pn = (wgid % nig) / gsz; return true;
    }
};

template <class Epi>
__device__ __forceinline__ void gemm_phase(LAS unsigned char* lds, const Gemm g, const StaticOrder& S, const Epi& E) {
    int tid_ = threadIdx.x; asm volatile("" : "+v"(tid_));
    const int tid = tid_, wid = __builtin_amdgcn_readfirstlane(tid >> 6), lane = tid & 63, wr = wid >> 2, wc = wid & 3, fr = lane & 15, fq = lane >> 4;
    const int K = g.K, nt = K / BK;
    unsigned voffA[2], voffB[2];
#pragma unroll
    for (int i = 0; i < 2; ++i) { int R, C; stage_rc(tid * 16 + i * 8192, R, C); const int Rb = (R & ~31) + perm32(R & 31);
        voffA[i] = (unsigned)(R * g.lda + C) * 2u; voffB[i] = (unsigned)(Rb * g.ldb + C) * 2u; }
    const size_t kstep = (size_t)(BK * 2);
    const size_t hstepA = (size_t)HALF * g.lda * 2, hstepB = (size_t)HALF * g.ldb * 2;
    const size_t tstepA = 2 * hstepA, tstepB = 2 * hstepB;
    const unsigned ldsw = (unsigned)wid * 1024u;
    const int aoff = lds_byte(wr * 64 + fr, fq * 8), boff = lds_byte(wc * 32 + fr, fq * 8);
#define PG8_SA(b, h) (((b) * 2 + (h)) * HTB)
#define PG8_SB(b, h) ((4 + (b) * 2 + (h)) * HTB)
#define PG8_STAGE(bufoff, gbase, voff) do { _Pragma("unroll") for (int _i = 0; _i < 2; ++_i) \
        __builtin_amdgcn_global_load_lds((const unsigned*)((const char*)(gbase) + (voff)[_i]), (LAS unsigned*)(lds + (bufoff) + ldsw + _i * 8192), 16, 0, 0); } while (0)
#define PG8_LDA(dst, b, h) do { _Pragma("unroll") for (int m = 0; m < 4; ++m) _Pragma("unroll") for (int k = 0; k < 2; ++k) dst[m][k] = *(const LAS bf16x8*)(lds + PG8_SA(b, h) + aoff + m * 2048 + k * 1024); } while (0)
#define PG8_LDB(dst, b, h) do { _Pragma("unroll") for (int n = 0; n < 2; ++n) _Pragma("unroll") for (int k = 0; k < 2; ++k) dst[n][k] = *(const LAS bf16x8*)(lds + PG8_SB(b, h) + boff + n * 2048 + k * 1024); } while (0)
#define PG8_MMA(ai, bj, At, Bt) do { __builtin_amdgcn_s_setprio(1); _Pragma("unroll") for (int m = 0; m < 4; ++m) _Pragma("unroll") for (int n = 0; n < 2; ++n) _Pragma("unroll") for (int k = 0; k < 2; ++k) \
        acc[ai][bj][m][n] = __builtin_amdgcn_mfma_f32_16x16x32_bf16(Bt[n][k], At[m][k], acc[ai][bj][m][n], 0, 0, 0); __builtin_amdgcn_s_setprio(0); } while (0)
#define PG8_WAIT_V(n) asm volatile("s_waitcnt vmcnt(" #n ")" ::: "memory")
#define PG8_WAIT_L(n) asm volatile("s_waitcnt lgkmcnt(" #n ")" ::: "memory")
#define PG8_BAR __builtin_amdgcn_s_barrier()
#define PG8_SCHED __builtin_amdgcn_sched_barrier(0)
    Unit cur, nxt; int ui = 0;
    if (!S.next(0, cur)) return;
    f32x4 acc[2][2][4][2];
#pragma unroll
    for (int a = 0; a < 2; ++a)
#pragma unroll
        for (int b = 0; b < 2; ++b)
#pragma unroll
            for (int m = 0; m < 4; ++m)
#pragma unroll
                for (int n = 0; n < 2; ++n) acc[a][b][m][n] = (f32x4){0.f, 0.f, 0.f, 0.f};
    bf16x8 At[4][2], B0[2][2], B1[2][2];
    const char* cA = (const char*)g.A + (size_t)cur.pm * tstepA; const char* cB = (const char*)g.Bt + (size_t)cur.pn * tstepB;
    PG8_STAGE(PG8_SB(0, 0), cB, voffB); PG8_STAGE(PG8_SB(0, 1), cB + hstepB, voffB); PG8_STAGE(PG8_SA(0, 0), cA, voffA); PG8_STAGE(PG8_SA(0, 1), cA + hstepA, voffA);
    if (wr == 1) PG8_BAR;
    PG8_WAIT_V(2); PG8_BAR;
    PG8_STAGE(PG8_SB(1, 0), cB + kstep, voffB); PG8_STAGE(PG8_SA(1, 0), cA + kstep, voffA); PG8_STAGE(PG8_SB(1, 1), cB + hstepB + kstep, voffB);
    PG8_WAIT_V(6); PG8_BAR;
    for (;;) {
        const bool has_next = S.next(ui + 1, nxt);
        const char* nA = has_next ? (const char*)g.A + (size_t)nxt.pm * tstepA : cA; const char* nB = has_next ? (const char*)g.Bt + (size_t)nxt.pn * tstepB : cB;
        for (int t = 0; t < nt; t += 2) {
            if constexpr (Epi::HAS_MID) { if (t == E.mid_t) E.mid(acc, cur, wr, wc, fr, fq); }
            const bool last = (t == nt - 2);
            const char* a1 = cA + (size_t)(t + 1) * kstep;
            const char* a2 = last ? nA : cA + (size_t)(t + 2) * kstep; const char* b2 = last ? nB : cB + (size_t)(t + 2) * kstep;
            const char* a3 = a2 + kstep; const char* b3 = b2 + kstep;
            PG8_LDB(B0, 0, 0); PG8_LDB(B1, 0, 1); PG8_SCHED; PG8_LDA(At, 0, 0); PG8_STAGE(PG8_SA(1, 1), a1 + hstepA, voffA);
            PG8_WAIT_V(8); PG8_WAIT_L(0); PG8_BAR; PG8_MMA(0, 0, At, B0); PG8_MMA(0, 1, At, B1); PG8_BAR; PG8_SCHED;
            PG8_LDA(At, 0, 1); PG8_STAGE(PG8_SB(0, 0), b2, voffB); PG8_STAGE(PG8_SB(0, 1), b2 + hstepB, voffB); PG8_STAGE(PG8_SA(0, 0), a2, voffA);
            PG8_WAIT_V(8); PG8_WAIT_L(0); PG8_BAR; PG8_MMA(1, 0, At, B0); PG8_MMA(1, 1, At, B1); PG8_BAR; PG8_SCHED;
            PG8_LDB(B0, 1, 0); PG8_LDB(B1, 1, 1); PG8_SCHED; PG8_LDA(At, 1, 0); PG8_STAGE(PG8_SA(0, 1), a2 + hstepA, voffA);
            PG8_WAIT_V(8); PG8_WAIT_L(0); PG8_BAR; PG8_MMA(0, 0, At, B0); PG8_MMA(0, 1, At, B1); PG8_BAR; PG8_SCHED;
            PG8_LDA(At, 1, 1); PG8_STAGE(PG8_SB(1, 0), b3, voffB); PG8_STAGE(PG8_SB(1, 1), b3 + hstepB, voffB); PG8_STAGE(PG8_SA(1, 0), a3, voffA);
            PG8_WAIT_V(8); PG8_WAIT_L(0); PG8_BAR; PG8_MMA(1, 0, At, B0); PG8_MMA(1, 1, At, B1); PG8_BAR; PG8_SCHED;
        }
        if (wr == 0) PG8_BAR;
        E(acc, cur, wr, wc, fr, fq);
        if (!has_next) break;
#pragma unroll
        for (int a = 0; a < 2; ++a)
#pragma unroll
            for (int b = 0; b < 2; ++b)
#pragma unroll
                for (int m = 0; m < 4; ++m)
#pragma unroll
                    for (int n = 0; n < 2; ++n) acc[a][b][m][n] = (f32x4){0.f, 0.f, 0.f, 0.f};
        cur = nxt; cA = nA; cB = nB; ++ui;
        if (wr == 1) PG8_BAR;
    }
    PG8_WAIT_V(0);
    PG8_BAR;
#undef PG8_SA
#undef PG8_SB
#undef PG8_STAGE
#undef PG8_LDA
#undef PG8_LDB
#undef PG8_MMA
#undef PG8_WAIT_V
#undef PG8_WAIT_L
#undef PG8_BAR
#undef PG8_SCHED
}

typedef f32x4 Acc[2][2][4][2];

struct EpiProj {
    static constexpr bool HAS_MID = false; int mid_t;
    bf16_t* O; int ldc;
    template <int ACT> __device__ __forceinline__ void body(const Acc& acc, const Unit& u, int wr, int wc, int fr, int fq) const {
        const int row0 = u.pm * BM + wr * 64 + fr, col0 = u.pn * BM + wc * 32 + 8 * fq;
#pragma unroll
        for (int ai = 0; ai < 2; ++ai)
#pragma unroll
            for (int m = 0; m < 4; ++m) { bf16_t* rowp = O + (size_t)(row0 + ai * HALF + m * 16) * ldc + col0;
#pragma unroll
                for (int bj = 0; bj < 2; ++bj) { f32x4 v0 = acc[ai][bj][m][0], v1 = acc[ai][bj][m][1];
                    if (ACT == 1) {
#pragma unroll
                        for (int e = 0; e < 4; ++e) { v0[e] = gelu_tanh(v0[e]); v1[e] = gelu_tanh(v1[e]); } }
                    if (ACT == 2) { v0 = v0 * 0.125f; v1 = v1 * 0.125f; }
                    if (ACT == 3) {
#pragma unroll
                        for (int e = 0; e < 4; ++e) { v0[e] = fast_sigmoid(v0[e]); v1[e] = fast_sigmoid(v1[e]); } }
                    if (ACT == 4) {
#pragma unroll
                        for (int e = 0; e < 4; ++e) { const float a = fmaxf(v0[e], 0.f), b = fmaxf(v1[e], 0.f); v0[e] = a * a; v1[e] = b * b; } }
                    u32x4 w; w.x = cvt_pk_bf16(v0[0], v0[1]); w.y = cvt_pk_bf16(v0[2], v0[3]); w.z = cvt_pk_bf16(v1[0], v1[1]); w.w = cvt_pk_bf16(v1[2], v1[3]);
                    *(u32x4*)(rowp + bj * HALF) = w; } }
    }
    __device__ __forceinline__ void operator()(const Acc& acc, const Unit& u, int wr, int wc, int fr, int fq) const {
        const int pn = u.pn;
        if (pn < 8) body<0>(acc, u, wr, wc, fr, fq);
        else if (pn < 16) body<1>(acc, u, wr, wc, fr, fq);
        else if (pn < 24) body<2>(acc, u, wr, wc, fr, fq);
        else if (pn < 26) body<0>(acc, u, wr, wc, fr, fq);
        else body<3>(acc, u, wr, wc, fr, fq);
    }
};
struct EpiFF1 {
    static constexpr bool HAS_MID = false; int mid_t;
    bf16_t* O; int ldc;
    __device__ __forceinline__ void operator()(const Acc& acc, const Unit& u, int wr, int wc, int fr, int fq) const {
        EpiProj e{0, O, ldc}; e.body<4>(acc, u, wr, wc, fr, fq);
    }
};
struct EpiRes {
    static constexpr bool HAS_MID = false; int mid_t;
    const float* base; float* out; const float* gate;
    __device__ __forceinline__ void operator()(const Acc& acc, const Unit& u, int wr, int wc, int fr, int fq) const {
        const int row0 = u.pm * BM + wr * 64 + fr, col0 = u.pn * BM + wc * 32 + 8 * fq;
        const float* gp = gate + (size_t)(u.pm >> 4) * NMOD + col0;
        f32x4 gv[2][2];
#pragma unroll
        for (int bj = 0; bj < 2; ++bj)
#pragma unroll
            for (int n = 0; n < 2; ++n) gv[bj][n] = *(const f32x4*)(gp + bj * HALF + 4 * n);
#pragma unroll
        for (int ai = 0; ai < 2; ++ai) {
            f32x4 bs[4][2][2];
#pragma unroll
            for (int m = 0; m < 4; ++m) { const size_t off = (size_t)(row0 + ai * HALF + m * 16) * DM + col0;
#pragma unroll
                for (int bj = 0; bj < 2; ++bj)
#pragma unroll
                    for (int n = 0; n < 2; ++n) bs[m][bj][n] = *(const f32x4*)(base + off + bj * HALF + 4 * n); }
#pragma unroll
            for (int m = 0; m < 4; ++m) { const size_t off = (size_t)(row0 + ai * HALF + m * 16) * DM + col0;
#pragma unroll
                for (int bj = 0; bj < 2; ++bj)
#pragma unroll
                    for (int n = 0; n < 2; ++n) *(f32x4*)(out + off + bj * HALF + 4 * n) = bs[m][bj][n] + gv[bj][n] * acc[ai][bj][m][n]; }
            asm volatile("" ::: "memory"); }
    }
};
struct EpiMerge {
    static constexpr bool HAS_MID = true; int mid_t;
    const bf16_t* P; bf16_t* O;
    __device__ __forceinline__ void mid(Acc& acc, const Unit& u, int wr, int wc, int fr, int fq) const {
        int row0 = u.pm * BM + wr * 64 + fr, col0 = u.pn * BM + wc * 32 + 8 * fq;
        asm volatile("" : "+v"(row0), "+v"(col0));
#pragma unroll
        for (int ai = 0; ai < 2; ++ai)
#pragma unroll
            for (int m = 0; m < 4; ++m) { const bf16_t* rp = P + (size_t)(row0 + ai * HALF + m * 16) * INW + col0;
#pragma unroll
                for (int bj = 0; bj < 2; ++bj) { const u32x4 a = *(const u32x4*)(rp + C_GA + bj * HALF), b = *(const u32x4*)(rp + C_GB + bj * HALF);
#pragma unroll
                    for (int e = 0; e < 4; ++e) { const float r0 = bf_lo(a[e]) * __builtin_amdgcn_rcpf(fmaxf(bf_lo(b[e]), 1e-30f)), r1 = bf_hi(a[e]) * __builtin_amdgcn_rcpf(fmaxf(bf_hi(b[e]), 1e-30f));
                        acc[ai][bj][m][e >> 1][(e & 1) * 2] *= r0; acc[ai][bj][m][e >> 1][(e & 1) * 2 + 1] *= r1; } }
                asm volatile("" ::: "memory"); }
    }
    __device__ __forceinline__ void operator()(const Acc& acc, const Unit& u, int wr, int wc, int fr, int fq) const {
        const int row0 = u.pm * BM + wr * 64 + fr, col0 = u.pn * BM + wc * 32 + 8 * fq;
#pragma unroll
        for (int ai = 0; ai < 2; ++ai)
#pragma unroll
            for (int m = 0; m < 4; ++m) { const size_t row = (size_t)(row0 + ai * HALF + m * 16);
#pragma unroll
                for (int bj = 0; bj < 2; ++bj) { const u32x4 b = *(const u32x4*)(P + row * INW + C_GB + col0 + bj * HALF);
                    const f32x4 v0 = acc[ai][bj][m][0], v1 = acc[ai][bj][m][1];
                    u32x4 w; w.x = cvt_pk_bf16(v0[0] * bf_lo(b[0]), v0[1] * bf_hi(b[0])); w.y = cvt_pk_bf16(v0[2] * bf_lo(b[1]), v0[3] * bf_hi(b[1]));
                    w.z = cvt_pk_bf16(v1[0] * bf_lo(b[2]), v1[1] * bf_hi(b[2])); w.w = cvt_pk_bf16(v1[2] * bf_lo(b[3]), v1[3] * bf_hi(b[3]));
                    *(u32x4*)(O + row * DM + col0 + bj * HALF) = w; }
                asm volatile("" ::: "memory"); }
    }
};
}

__device__ __forceinline__ void phase_mod(const Params& p, unsigned char* lds, int tid, int lane, int wid, int G, int bid) {
    float* cs = (float*)lds;
    float* red = (float*)(lds + 65536);
    float* mod = (float*)(p.ws + WS_MOD);
    for (int item = bid; item < NMOD / 64; item += G) {
        for (int e = tid; e < NB * DM; e += 512) { const int b = e >> 11, k = e & 2047; const float v = p.c[e]; cs[k * 8 + b] = v * fast_sigmoid(v); }
        __syncthreads();
        const int col = item * 64 + lane;
        float acc[8];
#pragma unroll
        for (int b = 0; b < 8; ++b) acc[b] = 0.f;
        const float* W = p.w_ada + (size_t)(wid * 256) * NMOD + col;
#pragma unroll 8
        for (int k = 0; k < 256; ++k) {
            const float w = W[(size_t)k * NMOD];
            const f32x4 c0 = *(const f32x4*)(cs + (wid * 256 + k) * 8), c1 = *(const f32x4*)(cs + (wid * 256 + k) * 8 + 4);
            acc[0] += c0[0] * w; acc[1] += c0[1] * w; acc[2] += c0[2] * w; acc[3] += c0[3] * w;
            acc[4] += c1[0] * w; acc[5] += c1[1] * w; acc[6] += c1[2] * w; acc[7] += c1[3] * w;
        }
#pragma unroll
        for (int b = 0; b < 8; ++b) red[(wid * 8 + b) * 64 + lane] = acc[b];
        __syncthreads();
        { const int b = tid >> 6; float s = 0.f;
#pragma unroll
          for (int w = 0; w < 8; ++w) s += red[(w * 8 + b) * 64 + lane];
          mod[b * NMOD + col] = s + p.b_ada[col]; }
        __syncthreads();
    }
}
__device__ __forceinline__ void transpose_item(const float* W, int ldw, bf16_t* WT, int ldo, int koff, int nblk, int item, float* scr, int lane) {
    const int kb = item / nblk, nb = item - kb * nblk, k0 = 64 * kb, n0 = 32 * nb;
    { const int kr = lane >> 3, nc = lane & 7; f32x4 v[8];
#pragma unroll
      for (int i = 0; i < 8; ++i) v[i] = *(const f32x4*)(W + (size_t)(k0 + 8 * i + kr) * ldw + n0 + 4 * nc);
#pragma unroll
      for (int i = 0; i < 8; ++i) { float* d = scr + (8 * i + kr) * 33 + 4 * nc; d[0] = v[i][0]; d[1] = v[i][1]; d[2] = v[i][2]; d[3] = v[i][3]; } }
    asm volatile("s_waitcnt lgkmcnt(0)" ::: "memory");
    const int c = lane & 7;
#pragma unroll
    for (int j = 0; j < 4; ++j) { const int n = (lane >> 3) + 8 * j; const float* s = scr + (8 * c) * 33 + n;
        u32x4 o; o.x = cvt_pk_bf16(s[0 * 33], s[1 * 33]); o.y = cvt_pk_bf16(s[2 * 33], s[3 * 33]); o.z = cvt_pk_bf16(s[4 * 33], s[5 * 33]); o.w = cvt_pk_bf16(s[6 * 33], s[7 * 33]);
        *(u32x4*)(WT + (size_t)(n0 + n) * ldo + koff + k0 + 8 * c) = o; }
    asm volatile("s_waitcnt lgkmcnt(0)" ::: "memory");
}
__device__ __forceinline__ void phase_weights(const Params& p, unsigned char* lds, int lane, int wid, int G, int bid) {
    float* scr = (float*)(lds + wid * 16384);
    const int gw = bid * 8 + wid, NGW = G * 8;
    constexpr int I_IN = 32 * (INW / 32), I_SQ = 32 * 64, I_F1 = 32 * (DFF / 32), I_F2 = (DFF / 64) * 64, I_L = 32 * 4;
    constexpr int NITEMS = I_IN + 3 * I_SQ + I_F1 + I_F2 + 2 * I_L;
    for (int it = gw; it < NITEMS; it += NGW) {
        int r = it;
        if (r < I_IN) { transpose_item(p.w_in, INW, (bf16_t*)(p.ws + WS_WIN), DM, 0, INW / 32, r, scr, lane); continue; } r -= I_IN;
        if (r < I_SQ) { transpose_item(p.w_lru_out, DM, (bf16_t*)(p.ws + WS_WM), 4096, 0, 64, r, scr, lane); continue; } r -= I_SQ;
        if (r < I_SQ) { transpose_item(p.w_attn_out, DM, (bf16_t*)(p.ws + WS_WM), 4096, 2048, 64, r, scr, lane); continue; } r -= I_SQ;
        if (r < I_SQ) { transpose_item(p.w_out, DM, (bf16_t*)(p.ws + WS_WO), DM, 0, 64, r, scr, lane); continue; } r -= I_SQ;
        if (r < I_F1) { transpose_item(p.w_ff1, DFF, (bf16_t*)(p.ws + WS_W1), DM, 0, DFF / 32, r, scr, lane); continue; } r -= I_F1;
        if (r < I_F2) { transpose_item(p.w_ff2, DM, (bf16_t*)(p.ws + WS_W2), DFF, 0, 64, r, scr, lane); continue; } r -= I_F2;
        if (r < I_L) { transpose_item(p.lru_wa, 128, (bf16_t*)(p.ws + WS_WA), DM, 0, 4, r, scr, lane); continue; } r -= I_L;
        transpose_item(p.lru_wx, 128, (bf16_t*)(p.ws + WS_WX), DM, 0, 4, r, scr, lane);
    }
}
__device__ __forceinline__ void phase_norm_mod(const float* X, const float* g, const float* mod, int shift_off, int scale_off, bf16_t* H, int lane, int wid, int G, int bid) {
    const int gw = bid * 8 + wid, NGW = G * 8;
    for (int grp = gw; grp < MTOK / 16; grp += NGW) {
        const int row0 = grp * 16, b = row0 / SEQ;
        f32x4 cA[8], cB[8];
#pragma unroll
        for (int j = 0; j < 8; ++j) { const int col = 4 * lane + 256 * j; const f32x4 gg = *(const f32x4*)(g + col), sc = *(const f32x4*)(mod + (size_t)b * NMOD + scale_off + col);
            cA[j] = gg * (sc + 1.0f); cB[j] = *(const f32x4*)(mod + (size_t)b * NMOD + shift_off + col); }
        for (int r = 0; r < 16; ++r) {
            const float* xr = X + (size_t)(row0 + r) * DM + 4 * lane; f32x4 v[8]; float ss = 0.f;
#pragma unroll
            for (int j = 0; j < 8; ++j) { v[j] = *(const f32x4*)(xr + 256 * j); ss += (v[j][0] * v[j][0] + v[j][1] * v[j][1]) + (v[j][2] * v[j][2] + v[j][3] * v[j][3]); }
            const float rstd = rsqrtf(wave_sum(ss) * (1.0f / DM) + EPS);
            bf16_t* orow = H + (size_t)(row0 + r) * DM + 4 * lane;
#pragma unroll
            for (int j = 0; j < 8; ++j) { const f32x4 o = v[j] * rstd * cA[j] + cB[j]; u32x2 w; w.x = cvt_pk_bf16(o[0], o[1]); w.y = cvt_pk_bf16(o[2], o[3]); *(u32x2*)(orow + 256 * j) = w; }
        }
    }
}
__device__ __forceinline__ void phase_final_norm(float* X, const float* g, int lane, int wid, int G, int bid) {
    const int gw = bid * 8 + wid, NGW = G * 8;
    f32x4 cA[8];
#pragma unroll
    for (int j = 0; j < 8; ++j) cA[j] = *(const f32x4*)(g + 4 * lane + 256 * j);
    for (int row = gw; row < MTOK; row += NGW) {
        float* xr = X + (size_t)row * DM + 4 * lane; f32x4 v[8]; float ss = 0.f;
#pragma unroll
        for (int j = 0; j < 8; ++j) { v[j] = *(const f32x4*)(xr + 256 * j); ss += (v[j][0] * v[j][0] + v[j][1] * v[j][1]) + (v[j][2] * v[j][2] + v[j][3] * v[j][3]); }
        const float rstd = rsqrtf(wave_sum(ss) * (1.0f / DM) + EPS);
#pragma unroll
        for (int j = 0; j < 8; ++j) *(f32x4*)(xr + 256 * j) = v[j] * rstd * cA[j];
    }
}

__device__ __forceinline__ void phase_lru(const Params& p, unsigned char* lds, int tid, int lane, int wid, int G, int bid) {
    bf16_t* PROJ = (bf16_t*)(p.ws + WS_PROJ);
    const bf16_t* WaT = (const bf16_t*)(p.ws + WS_WA); const bf16_t* WxT = (const bf16_t*)(p.ws + WS_WX);
    unsigned char* XC = lds;
    float* AS = (float*)(lds + 69632);
    float* US = (float*)(lds + 102400);
    float* SEG = (float*)(lds + 135168);
    float* CAR = (float*)(lds + 139264);
    unsigned char* WB = lds + 139520;
    const int r32 = lane & 31, hi = lane >> 5;
    for (int item = bid; item < 512; item += G) {
        const int b = item >> 6, hblk = (item >> 2) & 15, jq = item & 3;
        const int cg4 = tid & 31, ts = tid >> 5;
        const int chbase = hblk * 128 + cg4 * 4;
#pragma unroll
        for (int q = 0; q < 2; ++q) { const int idx = tid + 512 * q, mat = idx >> 9, j = (idx >> 4) & 31, ch = idx & 15;
            const u32x4 w = *(const u32x4*)((mat ? WxT : WaT) + (size_t)(32 * jq + j) * DM + hblk * 128 + 8 * ch);
            *(u32x4*)(WB + (mat * 32 + j) * 272 + ch * 16) = w; }
        const int jj = hblk * 128 + 32 * jq + r32;
        const float nba = -LOG2E * p.lru_ba[jj], nbx = -LOG2E * p.lru_bx[jj]; const float nsp = -LOG2E * 8.0f * log1pf(expf(-p.lru_lambda[jj]));
        if (tid < 32) CAR[tid] = 0.f;
        u32x2 xr[19];
#pragma unroll
        for (int i = 0; i < 19; ++i) { const int tr = 16 * ts - 3 + i; xr[i] = (u32x2){0u, 0u};
            if (tr >= 0) xr[i] = *(const u32x2*)(PROJ + (size_t)((long)b * SEQ + tr) * INW + C_LX + chbase); }
        for (int c = 0; c < 16; ++c) {
            const int t0 = c * 256; const size_t tokbase = (size_t)b * SEQ + t0;
            f32x4 cw[4], cb;
            { const float* cwp = p.conv_w + chbase; const float* cbp = p.conv_b + chbase; asm volatile("" : "+v"(cwp), "+v"(cbp));
#pragma unroll
              for (int k = 0; k < 4; ++k) cw[k] = *(const f32x4*)(cwp + k * DM);
              cb = *(const f32x4*)(cbp); }
            { f32x4 o[16];
#pragma unroll
              for (int i = 0; i < 19; ++i) { const f32x4 xf = (f32x4){bf_lo(xr[i][0]), bf_hi(xr[i][0]), bf_lo(xr[i][1]), bf_hi(xr[i][1])};
#pragma unroll
                  for (int k = 0; k < 4; ++k) { const int tl = i - k;
                      if (tl >= 0 && tl < 16) o[tl] = (k == 0 ? cb : o[tl]) + cw[k] * xf; }
                  if (i >= 3) { const int tl = i - 3;
                      u32x2 w; w.x = cvt_pk_bf16(o[tl][0], o[tl][1]); w.y = cvt_pk_bf16(o[tl][2], o[tl][3]);
                      *(u32x2*)(XC + (16 * ts + tl) * 272 + cg4 * 8) = w; }
                  __builtin_amdgcn_sched_barrier(0); } }
            __syncthreads();
            f32x16 pa = {}, px = {};
#pragma unroll
            for (int s = 0; s < 8; ++s) { const bf16x8 af = *(const bf16x8*)(XC + (32 * wid + r32) * 272 + (16 * s + 8 * hi) * 2);
                const bf16x8 fa = *(const bf16x8*)(WB + r32 * 272 + (16 * s + 8 * hi) * 2), fx = *(const bf16x8*)(WB + (32 + r32) * 272 + (16 * s + 8 * hi) * 2);
                pa = __builtin_amdgcn_mfma_f32_32x32x16_bf16(af, fa, pa, 0, 0, 0); px = __builtin_amdgcn_mfma_f32_32x32x16_bf16(af, fx, px, 0, 0, 0); }
#pragma unroll
            for (int reg = 0; reg < 16; ++reg) { const int t = 32 * wid + (reg & 3) + 8 * (reg >> 2) + 4 * hi;
                const float xcv = __uint_as_float(((unsigned)*(const bf16_t*)(XC + t * 272 + (32 * jq + r32) * 2)) << 16);
                const float rg = __builtin_amdgcn_rcpf(1.0f + __builtin_amdgcn_exp2f(pa[reg] * -LOG2E + nba)), ig = __builtin_amdgcn_rcpf(1.0f + __builtin_amdgcn_exp2f(px[reg] * -LOG2E + nbx));
                const float a = __builtin_amdgcn_exp2f(rg * nsp);
                const float mult = __builtin_amdgcn_sqrtf(fmaxf(1.0f - a * a, 0.f));
                AS[t * 32 + r32] = a; US[t * 32 + r32] = mult * ig * xcv;
                if ((reg & 3) == 3) __builtin_amdgcn_sched_barrier(0); }
            if (c == 0 && wid == 0 && hi == 0) {
                const float xcv = __uint_as_float(((unsigned)*(const bf16_t*)(XC + (32 * jq + r32) * 2)) << 16);
                US[r32] = __builtin_amdgcn_rcpf(1.0f + __builtin_amdgcn_exp2f(px[0] * -LOG2E + nbx)) * xcv; }
            __syncthreads();
            if (c < 15) {
#pragma unroll
                for (int i = 0; i < 19; ++i) xr[i] = *(const u32x2*)(PROJ + (size_t)((long)tokbase + 256 + 16 * ts - 3 + i) * INW + C_LX + chbase); }
            u32x4 gq2[2];
#pragma unroll
            for (int q = 0; q < 2; ++q) { const int idx = tid + 512 * q, t = idx >> 2, c8 = idx & 3; gq2[q] = *(const u32x4*)(PROJ + (tokbase + t) * INW + C_LG + hblk * 128 + 32 * jq + 8 * c8); }
            { const int j = tid & 31, seg = tid >> 5; float A = 1.f, h = 0.f; float av[16], uv[16];
#pragma unroll
              for (int tt = 0; tt < 16; ++tt) { const int idx = (16 * seg + tt) * 32 + j; av[tt] = AS[idx]; uv[tt] = US[idx]; }
#pragma unroll
              for (int tt = 0; tt < 16; ++tt) { h = av[tt] * h + uv[tt]; A *= av[tt]; }
              SEG[seg * 32 + j] = A; SEG[512 + seg * 32 + j] = h;
              __syncthreads();
              float hin = CAR[(c & 1) * 32 + j];
              for (int s2 = 0; s2 < seg; ++s2) hin = SEG[s2 * 32 + j] * hin + SEG[512 + s2 * 32 + j];
              h = hin;
#pragma unroll
              for (int tt = 0; tt < 16; ++tt) { h = av[tt] * h + uv[tt]; US[(16 * seg + tt) * 32 + j] = h; }
              if (seg == 15) CAR[((c + 1) & 1) * 32 + j] = h; }
            __syncthreads();
#pragma unroll
            for (int q = 0; q < 2; ++q) { const int idx = tid + 512 * q, t = idx >> 2, c8 = idx & 3;
                const f32x4 h0 = *(const f32x4*)(US + t * 32 + 8 * c8), h1 = *(const f32x4*)(US + t * 32 + 8 * c8 + 4);
                bf16_t* gp = PROJ + (tokbase + t) * INW + C_LG + hblk * 128 + 32 * jq + 8 * c8; const u32x4 gq = gq2[q];
                u32x4 w; w.x = cvt_pk_bf16(h0[0] * bf_lo(gq[0]), h0[1] * bf_hi(gq[0])); w.y = cvt_pk_bf16(h0[2] * bf_lo(gq[1]), h0[3] * bf_hi(gq[1]));
                w.z = cvt_pk_bf16(h1[0] * bf_lo(gq[2]), h1[1] * bf_hi(gq[2])); w.w = cvt_pk_bf16(h1[2] * bf_lo(gq[3]), h1[3] * bf_hi(gq[3]));
                *(u32x4*)gp = w; }
        }
        __syncthreads();
    }
}

__device__ __forceinline__ void phase_attn(const Params& p, unsigned char* lds, int tid, int lane, int wid, int G, int bid) {
    bf16_t* PROJ = (bf16_t*)(p.ws + WS_PROJ);
    unsigned char* KS = lds;
    unsigned char* VT = lds + 36864;
    float* BT = (float*)(lds + 70144);
    const int r32 = lane & 31, hi = lane >> 5;
    for (int u = bid; u < 1024; u += G) {
        const int hk = u & 3, n = (u >> 2) & 31, b = u >> 7;
#pragma unroll
        for (int q = 0; q < 4; ++q) { const int idx = tid + 512 * q, row = idx >> 3, ch = idx & 7; const int tok = 128 * (n - 1) + row;
            u32x4 kv = (u32x4){0u, 0u, 0u, 0u}, vv = kv;
            if (tok >= 0) { const bf16_t* base = PROJ + ((size_t)b * SEQ + tok) * INW; kv = *(const u32x4*)(base + C_K + hk * 64 + 8 * ch); vv = *(const u32x4*)(base + C_V + hk * 64 + 8 * ch); }
            *(u32x4*)(KS + row * 144 + ch * 16) = kv;
#pragma unroll
            for (int e = 0; e < 4; ++e) { *(bf16_t*)(VT + (8 * ch + 2 * e) * 520 + row * 2) = (bf16_t)(vv[e] & 0xffffu); *(bf16_t*)(VT + (8 * ch + 2 * e + 1) * 520 + row * 2) = (bf16_t)(vv[e] >> 16); } }
        for (int e = tid; e < 1536; e += 512) { const int g = e / 192, idx = e - g * 192, rel = idx - 32; float v = NEGF;
            if (rel >= 0 && rel < 128) { int bk = rel; if (rel >= 16) { bk = 16 + (int)(logf((float)rel * (1.0f / 16.0f)) / 2.0794415416798357f * 16.0f); bk = bk > 31 ? 31 : bk; }
                v = p.rel_bias[bk * 32 + hk * 8 + g]; }
            BT[e] = v; }
        __syncthreads();
        const int head = hk * 8 + wid; const float sink = p.attn_sinks[head];
        for (int i = 0; i < 4; ++i) {
            const size_t qtok = (size_t)b * SEQ + 128 * n + 32 * i + r32;
            bf16_t* qp = PROJ + qtok * INW + C_Q + head * 64;
            bf16x8 qf[4];
#pragma unroll
            for (int s = 0; s < 4; ++s) qf[s] = *(const bf16x8*)(qp + 16 * s + 8 * hi);
            f32x16 S[5];
#pragma unroll
            for (int dj = 0; dj < 5; ++dj) { f32x16 acc = {};
#pragma unroll
                for (int s = 0; s < 4; ++s) { const bf16x8 kf = *(const bf16x8*)(KS + (32 * (i + dj) + r32) * 144 + (16 * s + 8 * hi) * 2); acc = __builtin_amdgcn_mfma_f32_32x32x16_bf16(kf, qf[s], acc, 0, 0, 0); }
                S[dj] = acc; }
            float m = sink;
#pragma unroll
            for (int dj = 0; dj < 5; ++dj) { const bool dead = (n == 0) && (i + dj < 4);
#pragma unroll
                for (int reg = 0; reg < 16; ++reg) { const int kr = (reg & 3) + 8 * (reg >> 2) + 4 * hi; float v = S[dj][reg] + BT[wid * 192 + 160 - 32 * dj + r32 - kr]; v = dead ? NEGF : v; S[dj][reg] = v; m = fmaxf(m, v); } }
            m = fmaxf(m, __shfl_xor(m, 32));
            float l = 0.f; const float mb = m * LOG2E;
#pragma unroll
            for (int dj = 0; dj < 5; ++dj)
#pragma unroll
                for (int reg = 0; reg < 16; ++reg) { const float e = __builtin_amdgcn_exp2f(S[dj][reg] * LOG2E - mb); S[dj][reg] = e; l += e; }
            l += __shfl_xor(l, 32); l += __builtin_amdgcn_exp2f(sink * LOG2E - mb);
            const float inv = 1.0f / l;
            f32x16 O0 = {}, O1 = {};
#pragma unroll
            for (int dj = 0; dj < 5; ++dj)
#pragma unroll
                for (int ks = 0; ks < 2; ++ks) { u32x4 pw; pw.x = cvt_pk_bf16(S[dj][8 * ks + 0], S[dj][8 * ks + 1]); pw.y = cvt_pk_bf16(S[dj][8 * ks + 2], S[dj][8 * ks + 3]);
                    pw.z = cvt_pk_bf16(S[dj][8 * ks + 4], S[dj][8 * ks + 5]); pw.w = cvt_pk_bf16(S[dj][8 * ks + 6], S[dj][8 * ks + 7]);
                    const bf16x8 pf = __builtin_bit_cast(bf16x8, pw);
                    const unsigned char* vp = VT + r32 * 520 + (32 * (i + dj) + 16 * ks + 4 * hi) * 2;
                    { const u32x2 lo = *(const u32x2*)vp, h2 = *(const u32x2*)(vp + 16); const u32x4 vw = (u32x4){lo.x, lo.y, h2.x, h2.y};
                      O0 = __builtin_amdgcn_mfma_f32_32x32x16_bf16(__builtin_bit_cast(bf16x8, vw), pf, O0, 0, 0, 0); }
                    { const u32x2 lo = *(const u32x2*)(vp + 32 * 520), h2 = *(const u32x2*)(vp + 32 * 520 + 16); const u32x4 vw = (u32x4){lo.x, lo.y, h2.x, h2.y};
                      O1 = __builtin_amdgcn_mfma_f32_32x32x16_bf16(__builtin_bit_cast(bf16x8, vw), pf, O1, 0, 0, 0); } }
#pragma unroll
            for (int c4 = 0; c4 < 4; ++c4) { u32x2 w0, w1;
                w0.x = cvt_pk_bf16(O0[4 * c4] * inv, O0[4 * c4 + 1] * inv); w0.y = cvt_pk_bf16(O0[4 * c4 + 2] * inv, O0[4 * c4 + 3] * inv);
                w1.x = cvt_pk_bf16(O1[4 * c4] * inv, O1[4 * c4 + 1] * inv); w1.y = cvt_pk_bf16(O1[4 * c4 + 2] * inv, O1[4 * c4 + 3] * inv);
                *(u32x2*)(qp + 8 * c4 + 4 * hi) = w0; *(u32x2*)(qp + 32 + 8 * c4 + 4 * hi) = w1; }
        }
        __syncthreads();
    }
}


#define XB_TMO      128
#define XB_XCNT(j)  (256  + 64 * (j))
#define XB_XSUB(j)  (1280 + 64 * (j))
#define XB_XGEN(j)  (2304 + 64 * (j))
#define XB_TOP      3328
#define XB_TOPGEN   3392
#define XCD_BAR_WORDS 3456
#define XB_SPIN_CAP (1u << 22)
__device__ __forceinline__ unsigned xb_ld(unsigned* p)              { return __hip_atomic_load(p, __ATOMIC_RELAXED, __HIP_MEMORY_SCOPE_AGENT); }
__device__ __forceinline__ unsigned xb_add(unsigned* p, unsigned v) { return __hip_atomic_fetch_add(p, v, __ATOMIC_RELAXED, __HIP_MEMORY_SCOPE_AGENT); }
__device__ __forceinline__ unsigned xb_xcc_id() { return (unsigned)__builtin_amdgcn_s_getreg((3 << 11) | 20) & 0xFu; }
#define XB_SPIN(cond, bar) do { unsigned _sp = 0; while (cond) { __builtin_amdgcn_s_sleep(1); \
    if ((++_sp & 255u) == 0u) { if (xb_ld(&(bar)[XB_TMO])) break; if (_sp > XB_SPIN_CAP) { atomicAdd(&(bar)[XB_TMO], 1u); break; } } } } while (0)
struct XcdBarrier { unsigned* bar; unsigned x; volatile LAS unsigned* st; };
__device__ __forceinline__ XcdBarrier xcd_barrier_post(unsigned* bar, volatile LAS unsigned* st) {
    XcdBarrier b; b.bar = bar; b.x = xb_xcc_id(); b.st = st;
    if (threadIdx.x == 0) (void)xb_add(&bar[XB_XCNT(b.x)], 1u);
    return b;
}
__device__ __forceinline__ void xcd_barrier_complete(unsigned* bar, unsigned x, unsigned& nloc, unsigned& nx) {
    const unsigned G = gridDim.x * gridDim.y * gridDim.z;
    unsigned sum, cnt, mine, sp = 0u;
    for (;;) {
        sum = 0u; cnt = 0u; mine = 0u;
#pragma unroll
        for (unsigned j = 0; j < 16; ++j) { const unsigned c = xb_ld(&bar[XB_XCNT(j)]); sum += c; cnt += (c > 0u) ? 1u : 0u; mine = (j == x) ? c : mine; }
        if (sum == G) break;
        __builtin_amdgcn_s_sleep(1);
        if ((++sp & 255u) == 0u) { if (xb_ld(&bar[XB_TMO])) break; if (sp > XB_SPIN_CAP) { atomicAdd(&bar[XB_TMO], 1u); break; } }
    }
    nloc = mine > 0u ? mine : 1u; nx = cnt > 0u ? cnt : 1u;
}
__device__ __forceinline__ void xcd_barrier(const XcdBarrier& b) {
    asm volatile("s_waitcnt vmcnt(0)" ::: "memory");
    __syncthreads();
    if (threadIdx.x == 0) {
        unsigned* bar = b.bar;
        __builtin_amdgcn_s_waitcnt(0);
        unsigned nloc = b.st[0], nx = b.st[1];
        if (nloc == 0u) { xcd_barrier_complete(bar, b.x, nloc, nx); b.st[0] = nloc; b.st[1] = nx; }
        const unsigned old = xb_add(&bar[XB_XSUB(b.x)], 1u);
        const unsigned gen = old / nloc;
        if (old + 1u == (gen + 1u) * nloc) {
            __builtin_amdgcn_fence(__ATOMIC_RELEASE, "agent");
            asm volatile("s_waitcnt vmcnt(0)" ::: "memory");
            const unsigned og = xb_add(&bar[XB_TOP], 1u);
            const unsigned tg = og / nx;
            if (og + 1u == (tg + 1u) * nx) xb_add(&bar[XB_TOPGEN], 1u);
            else XB_SPIN(xb_ld(&bar[XB_TOPGEN]) == tg, bar);
            __builtin_amdgcn_fence(__ATOMIC_ACQUIRE, "agent");
            xb_add(&bar[XB_XGEN(b.x)], 1u);
            asm volatile("s_waitcnt vmcnt(0)" ::: "memory");
        } else {
            XB_SPIN(xb_ld(&bar[XB_XGEN(b.x)]) == gen, bar);
            __builtin_amdgcn_fence(__ATOMIC_ACQUIRE, "agent");
            asm volatile("s_waitcnt vmcnt(0)" ::: "memory");
        }
    }
    __syncthreads();
}

#ifndef PH_MASK
#define PH_MASK 0xFFFF
#endif
#define PH(k) if constexpr ((PH_MASK >> (k)) & 1)
__global__ void __launch_bounds__(512) fwd_megakernel(Params p) {
    extern __shared__ __attribute__((aligned(16))) unsigned char lds[];
    cg::grid_group grid = cg::this_grid();
    const int wid = __builtin_amdgcn_readfirstlane((int)threadIdx.x >> 6);
    const int G = gridDim.x, bid = blockIdx.x;
#define TIDS int tid = threadIdx.x; asm volatile("" : "+v"(tid)); const int lane = tid & 63; (void)lane;
    LAS unsigned char* lds3 = (LAS unsigned char*)lds;
    float* mod = (float*)(p.ws + WS_MOD);
    bf16_t* H = (bf16_t*)(p.ws + WS_H);
    bf16_t* PROJ = (bf16_t*)(p.ws + WS_PROJ);
    volatile LAS unsigned* bst = (volatile LAS unsigned*)(lds3 + LDS_BYTES - 64);
    if (threadIdx.x < 2) bst[threadIdx.x] = 0u;
    __syncthreads();
    const XcdBarrier xbar = xcd_barrier_post((unsigned*)(p.ws + WS_CTL), bst);
    if (p.ws == nullptr) grid.sync();
#ifdef PROBE_A
    unsigned long long ts_[12]; int nts_ = 0;
#define STAMP() do { ts_[nts_++] = __builtin_amdgcn_s_memrealtime(); } while (0)
#define GRID_SYNC() do { xcd_barrier(xbar); STAMP(); } while (0)
    STAMP();
#else
#define GRID_SYNC() xcd_barrier(xbar)
#endif

    PH(0) { TIDS phase_mod(p, lds, tid, lane, wid, G, bid); }
    PH(1) { TIDS phase_weights(p, lds, lane, wid, G, bid); }
    GRID_SYNC();
    PH(2) { TIDS phase_norm_mod(p.x, p.norm1_g, mod, 0, DM, H, lane, wid, G, bid); }
    GRID_SYNC();
    PH(3) { pg8::Gemm g{H, (const bf16_t*)(p.ws + WS_WIN), MTOK, INW, DM, DM, DM}; pg8::StaticOrder S; S.init(MTOK, INW, G, bid);
      pg8::EpiProj E{0, PROJ, INW}; pg8::gemm_phase(lds3, g, S, E); }
    GRID_SYNC();
    PH(4) { TIDS phase_lru(p, lds, tid, lane, wid, G, bid); }
    PH(5) { TIDS phase_attn(p, lds, tid, lane, wid, G, bid); }
    GRID_SYNC();
    PH(6) { pg8::Gemm g{PROJ + C_LG, (const bf16_t*)(p.ws + WS_WM), MTOK, DM, 4096, INW, 4096}; pg8::StaticOrder S; S.init(MTOK, DM, G, bid);
      pg8::EpiMerge E{32, PROJ, H}; pg8::gemm_phase(lds3, g, S, E); }
    GRID_SYNC();
    PH(7) { pg8::Gemm g{H, (const bf16_t*)(p.ws + WS_WO), MTOK, DM, DM, DM, DM}; pg8::StaticOrder S; S.init(MTOK, DM, G, bid);
      pg8::EpiRes E{0, p.x, p.out, mod + 2 * DM}; pg8::gemm_phase(lds3, g, S, E); }
    GRID_SYNC();
    PH(8) { TIDS phase_norm_mod(p.out, p.norm2_g, mod, 3 * DM, 4 * DM, H, lane, wid, G, bid); }
    GRID_SYNC();
    PH(9) { pg8::Gemm g{H, (const bf16_t*)(p.ws + WS_W1), MTOK, DFF, DM, DM, DM}; pg8::StaticOrder S; S.init(MTOK, DFF, G, bid);
      pg8::EpiFF1 E{0, PROJ, DFF}; pg8::gemm_phase(lds3, g, S, E); }
    GRID_SYNC();
    PH(10) { pg8::Gemm g{PROJ, (const bf16_t*)(p.ws + WS_W2), MTOK, DM, DFF, DFF, DFF}; pg8::StaticOrder S; S.init(MTOK, DM, G, bid);
      pg8::EpiRes E{0, p.out, p.out, mod + 5 * DM}; pg8::gemm_phase(lds3, g, S, E); }
    GRID_SYNC();
    PH(11) { TIDS phase_final_norm(p.out, p.final_g, lane, wid, G, bid); }
#ifdef PROBE_A
    GRID_SYNC();
    if (bid == 0 && threadIdx.x < 64) {
        const unsigned long long dA = ts_[PROBE_A + 1] - ts_[PROBE_A], dB = ts_[PROBE_B + 1] - ts_[PROBE_B];
        const int n = (int)(dB * 16ull / 100ull);
        for (int i = threadIdx.x; i < n; i += 64) p.out[i] += 0.125f;
        const unsigned long long t0 = __builtin_amdgcn_s_memrealtime();
        while (__builtin_amdgcn_s_memrealtime() - t0 < 8ull * dA) __builtin_amdgcn_s_sleep(8);
    }
#endif
}

extern "C" void kernel_launch(void* const* d_in, const int* in_sizes, int n_in, void* d_out, int out_size, void* d_ws, size_t ws_size, hipStream_t stream) {
    static int grid_blocks = 0;
    if (grid_blocks == 0) {
        if (n_in != 22 || ws_size < WS_END || out_size != MTOK * DM) { fprintf(stderr, "kernel_launch: unexpected shapes (n_in %d, ws %zu need %zu, out %d)\n", n_in, ws_size, (size_t)WS_END, out_size); grid_blocks = -1; return; }
        int dev = 0, cus = 0, per_cu = 0;
        hipGetDevice(&dev);
        hipDeviceGetAttribute(&cus, hipDeviceAttributeMultiprocessorCount, dev);
        hipFuncSetAttribute((const void*)fwd_megakernel, hipFuncAttributeMaxDynamicSharedMemorySize, LDS_BYTES);
        hipOccupancyMaxActiveBlocksPerMultiprocessor(&per_cu, (const void*)fwd_megakernel, 512, LDS_BYTES);
        if (per_cu < 1) { fprintf(stderr, "kernel_launch: occupancy query says %d blocks/CU\n", per_cu); per_cu = 1; }
        grid_blocks = cus * per_cu;
    }
    if (grid_blocks < 0) return;
    Params p{};
    const float** pp = (const float**)&p;
    for (int i = 0; i < 22; ++i) pp[i] = (const float*)d_in[i];
    p.out = (float*)d_out; p.ws = (unsigned char*)d_ws;
    if (hipMemsetAsync((unsigned char*)d_ws + WS_CTL, 0, CTL_BYTES, stream) != hipSuccess) { fprintf(stderr, "kernel_launch: memset of barrier words failed\n"); return; }
    void* args[] = {&p};
    hipError_t e = hipLaunchCooperativeKernel((const void*)fwd_megakernel, dim3(grid_blocks), dim3(512), args, LDS_BYTES, stream);
    if (e != hipSuccess) fprintf(stderr, "cooperative launch failed: %s (grid %d)\n", hipGetErrorString(e), grid_blocks);
}
```
